# Optimizing an MI355X kernel written in HIP

```python
import jax, jax.numpy as jnp
from jax import lax
import numpy as np

D_MODEL = 1024
BATCH = 16
SEQ = 2048
DEPTH = 1

MIX_WIDTH = D_MODEL
MOBA_HEAD_DIM = 64
MOBA_WIDTH = MIX_WIDTH // 2
MOBA_HEADS = MOBA_WIDTH // MOBA_HEAD_DIM
MOBA_BLOCK = 256
MOBA_TOPK = 3
MOBA_Q_CHUNK = 64
GDN_HEAD_DIM = 128
GDN_WIDTH = MIX_WIDTH - MOBA_WIDTH
GDN_HEADS = GDN_WIDTH // GDN_HEAD_DIM
GDN_CONV = 4
GDN_CHUNK = 64
N_GROUPS = 4
EXPERTS_PER_GROUP = 8
EXPERT_TOPK = 2
EXPERT_FF = D_MODEL // 4
RMS_EPS = 1e-6
IN_SPLITS = (MOBA_WIDTH, MOBA_WIDTH, MOBA_WIDTH, 3 * GDN_WIDTH, GDN_WIDTH, GDN_HEADS, GDN_HEADS)
IN_PROJ_WIDTH = 3 * MOBA_WIDTH + 4 * GDN_WIDTH + 2 * GDN_HEADS

kernel_name = 'hybrid_moba_gdn_hmoe'


def rmsnorm(x, gain):
    x32 = x.astype(jnp.float32)
    y = x32 * lax.rsqrt(jnp.mean(x32 * x32, axis=-1, keepdims=True) + RMS_EPS)
    return (y * gain.astype(jnp.float32)).astype(x.dtype)


def l2norm(x):
    return x * lax.rsqrt(jnp.sum(x * x, axis=-1, keepdims=True) + 1e-6)


def moba_attention(q, k, v):
    B, S, H, Dh = q.shape
    nb = -(-S // MOBA_BLOCK)
    pad = nb * MOBA_BLOCK - S
    topk = min(MOBA_TOPK, nb)
    scale = Dh ** -0.5
    q = q.transpose(0, 2, 1, 3)
    kp = jnp.pad(k.transpose(0, 2, 1, 3), ((0, 0), (0, 0), (0, pad), (0, 0)))
    vp = jnp.pad(v.transpose(0, 2, 1, 3), ((0, 0), (0, 0), (0, pad), (0, 0)))
    kb = kp.reshape(B, H, nb, MOBA_BLOCK, Dh)
    vb = vp.reshape(B, H, nb, MOBA_BLOCK, Dh)
    k_mean = jnp.mean(kb.astype(jnp.float32), axis=3)
    b_idx = jnp.arange(B)[:, None, None, None]
    h_idx = jnp.arange(H)[None, :, None, None]
    blk_ids = jnp.arange(nb)
    n_chunks = S // MOBA_Q_CHUNK

    def chunk(c):
        start = c * MOBA_Q_CHUNK
        qc = lax.dynamic_slice_in_dim(q, start, MOBA_Q_CHUNK, axis=2)
        qpos = start + jnp.arange(MOBA_Q_CHUNK)
        own = start // MOBA_BLOCK
        gate = jnp.einsum('bhqd,bhnd->bhqn', qc.astype(jnp.float32), k_mean)
        gate = jnp.where(blk_ids < own, gate, -jnp.inf)
        _, gidx = lax.top_k(gate, topk)
        sel_ok = jnp.arange(topk) < own
        k_sel = kb[b_idx, h_idx, gidx]
        v_sel = vb[b_idx, h_idx, gidx]
        s_sel = jnp.einsum('bhqd,bhqkld->bhqkl', qc, k_sel).astype(jnp.float32) * scale
        s_sel = jnp.where(sel_ok[:, None], s_sel, -jnp.inf)
        k_own = lax.dynamic_slice_in_dim(kb, own, 1, axis=2)[:, :, 0]
        v_own = lax.dynamic_slice_in_dim(vb, own, 1, axis=2)[:, :, 0]
        s_own = jnp.einsum('bhqd,bhld->bhql', qc, k_own).astype(jnp.float32) * scale
        kpos = own * MOBA_BLOCK + jnp.arange(MOBA_BLOCK)
        s_own = jnp.where(kpos[None, :] <= qpos[:, None], s_own, -jnp.inf)
        s = jnp.concatenate([s_sel.reshape(B, H, MOBA_Q_CHUNK, topk * MOBA_BLOCK), s_own], axis=-1)
        p = jax.nn.softmax(s, axis=-1).astype(v.dtype)
        p_sel = p[..., :topk * MOBA_BLOCK].reshape(B, H, MOBA_Q_CHUNK, topk, MOBA_BLOCK)
        p_own = p[..., topk * MOBA_BLOCK:]
        return (jnp.einsum('bhqkl,bhqkld->bhqd', p_sel, v_sel)
                + jnp.einsum('bhql,bhld->bhqd', p_own, v_own))

    out = lax.map(chunk, jnp.arange(n_chunks))
    return out.transpose(1, 0, 3, 2, 4).reshape(B, S, H, Dh)


def causal_depthwise_conv(x, w):
    C = x.shape[-1]
    return lax.conv_general_dilated(
        x, w[:, None, :].astype(x.dtype), window_strides=(1,),
        padding=((GDN_CONV - 1, 0),), dimension_numbers=('NWC', 'WIO', 'NWC'),
        feature_group_count=C)


def gated_delta_rule(q, k, v, g, beta):
    B, S, H, Dk = q.shape
    Dv = v.shape[-1]
    C = GDN_CHUNK
    N = S // C

    def to_chunks(t):
        return t.reshape(B, N, C, H, *t.shape[3:]).swapaxes(2, 3)

    q, k, v, g, beta = (to_chunks(t) for t in (q, k, v, g, beta))
    G = jnp.cumsum(g, axis=-1)
    incl = jnp.tril(jnp.ones((C, C), dtype=bool))
    strict = jnp.tril(jnp.ones((C, C), dtype=bool), k=-1)
    decay = jnp.exp(jnp.where(incl, G[..., :, None] - G[..., None, :], -jnp.inf))
    kk = jnp.einsum('bnhid,bnhjd->bnhij', k, k)
    A = jnp.where(strict, beta[..., :, None] * kk * decay, 0.0)
    eye = jnp.eye(C, dtype=A.dtype)
    gam = jnp.exp(G)
    rhs = jnp.concatenate([beta[..., None] * v, (beta * gam)[..., None] * k], axis=-1)
    sol = lax.linalg.triangular_solve(eye + A, rhs, left_side=True, lower=True, unit_diagonal=True)
    u_v, w = sol[..., :Dv], sol[..., Dv:]
    qk = jnp.einsum('bnhid,bnhjd->bnhij', q, k) * decay
    q_dec = q * gam[..., None]
    k_dec = k * jnp.exp(G[..., -1:] - G)[..., None]
    g_last = jnp.exp(G[..., -1])

    def step(state, xs):
        u_v_c, w_c, qk_c, q_dec_c, k_dec_c, g_last_c = xs
        u = u_v_c - jnp.einsum('bhck,bhkv->bhcv', w_c, state)
        o = jnp.einsum('bhck,bhkv->bhcv', q_dec_c, state) + jnp.einsum('bhij,bhjv->bhiv', qk_c, u)
        new_state = g_last_c[..., None, None] * state + jnp.einsum('bhck,bhcv->bhkv', k_dec_c, u)
        return new_state, o

    xs = tuple(t.swapaxes(0, 1) for t in (u_v, w, qk, q_dec, k_dec, g_last))
    state0 = jnp.zeros((B, H, Dk, Dv), dtype=q.dtype)
    _, o = lax.scan(step, state0, xs)
    return o.transpose(1, 0, 3, 2, 4).reshape(B, S, H, Dv)


def hierarchical_moe(h, w_group, w_router, w_gate, w_up, w_down):
    T = h.shape[0]
    group_logits = jnp.einsum('td,dg->tg', h, w_group).astype(jnp.float32)
    group_prob = jax.nn.softmax(group_logits, axis=-1)
    g_sel = jnp.argmax(group_logits, axis=-1)
    p_group = jnp.take_along_axis(group_prob, g_sel[:, None], axis=-1)
    expert_logits = jnp.einsum('td,de->te', h, w_router).astype(jnp.float32)
    expert_logits = expert_logits.reshape(T, N_GROUPS, EXPERTS_PER_GROUP)
    in_group = jnp.take_along_axis(expert_logits, g_sel[:, None, None], axis=1)[:, 0]
    in_prob = jax.nn.softmax(in_group, axis=-1)
    top_p, top_i = lax.top_k(in_prob, EXPERT_TOPK)
    top_p = top_p / jnp.sum(top_p, axis=-1, keepdims=True)
    within = jnp.sum(jax.nn.one_hot(top_i, EXPERTS_PER_GROUP, dtype=jnp.float32) * top_p[..., None], axis=1)
    combine = (jax.nn.one_hot(g_sel, N_GROUPS, dtype=jnp.float32)[:, :, None]
               * p_group[:, :, None] * within[:, None, :]).astype(h.dtype)
    y = jnp.zeros_like(h)
    for grp in range(N_GROUPS):
        hid = (jax.nn.silu(jnp.einsum('td,edf->tef', h, w_gate[grp]))
               * jnp.einsum('td,edf->tef', h, w_up[grp])) * combine[:, grp, :, None]
        y = y + jnp.einsum('tef,efd->td', hid, w_down[grp])
    return y


def setup_inputs(seed: int = 0) -> dict:
    key = jax.random.key(seed)
    ks = jax.random.split(key, 16)
    f32 = jnp.float32
    D = D_MODEL
    x = jax.random.normal(ks[0], (BATCH, SEQ, D), f32)
    attn_norm = 1.0 + 0.02 * jax.random.normal(ks[1], (DEPTH, D), f32)
    w_in = jax.random.normal(ks[2], (DEPTH, D, IN_PROJ_WIDTH), f32) * D ** -0.5
    conv_w = jax.random.normal(ks[3], (DEPTH, GDN_CONV, 3 * GDN_WIDTH), f32) * GDN_CONV ** -0.5
    A_log = jnp.log(jax.random.uniform(ks[4], (DEPTH, GDN_HEADS), f32, 1.0, 16.0))
    dt = jnp.exp(jax.random.uniform(ks[5], (DEPTH, GDN_HEADS), f32, np.log(1e-3), np.log(1e-1)))
    dt_bias = dt + jnp.log(-jnp.expm1(-dt))
    gdn_norm = 1.0 + 0.02 * jax.random.normal(ks[6], (DEPTH, GDN_HEAD_DIM), f32)
    w_out = jax.random.normal(ks[7], (DEPTH, MIX_WIDTH, D), f32) * MIX_WIDTH ** -0.5
    ffn_norm = 1.0 + 0.02 * jax.random.normal(ks[8], (DEPTH, D), f32)
    w_group = jax.random.normal(ks[9], (DEPTH, D, N_GROUPS), f32) * D ** -0.5
    w_router = jax.random.normal(ks[10], (DEPTH, D, N_GROUPS * EXPERTS_PER_GROUP), f32) * D ** -0.5
    w_gate = jax.random.normal(ks[11], (DEPTH, N_GROUPS, EXPERTS_PER_GROUP, D, EXPERT_FF), f32) * D ** -0.5
    w_up = jax.random.normal(ks[12], (DEPTH, N_GROUPS, EXPERTS_PER_GROUP, D, EXPERT_FF), f32) * D ** -0.5
    w_down = jax.random.normal(ks[13], (DEPTH, N_GROUPS, EXPERTS_PER_GROUP, EXPERT_FF, D), f32) * EXPERT_FF ** -0.5
    final_norm = 1.0 + 0.02 * jax.random.normal(ks[14], (D,), f32)
    return {'x': x, 'attn_norm': attn_norm, 'w_in': w_in, 'conv_w': conv_w, 'A_log': A_log,
            'dt_bias': dt_bias, 'gdn_norm': gdn_norm, 'w_out': w_out, 'ffn_norm': ffn_norm,
            'w_group': w_group, 'w_router': w_router, 'w_gate': w_gate, 'w_up': w_up,
            'w_down': w_down, 'final_norm': final_norm}


def reference(x, attn_norm, w_in, conv_w, A_log, dt_bias, gdn_norm, w_out, ffn_norm,
              w_group, w_router, w_gate, w_up, w_down, final_norm):
    B, S, D = x.shape
    offsets = np.cumsum(IN_SPLITS)[:-1].tolist()
    f32 = jnp.float32
    for l in range(DEPTH):
        h = rmsnorm(x, attn_norm[l])
        proj = jnp.einsum('bsd,de->bse', h, w_in[l])
        mq, mk, mv, gqkv, gz, ga, gb = jnp.split(proj, offsets, axis=-1)
        to_a = lambda t: t.reshape(B, S, MOBA_HEADS, MOBA_HEAD_DIM)
        y_a = moba_attention(to_a(mq), to_a(mk), to_a(mv)).reshape(B, S, MOBA_WIDTH)
        gqkv = jax.nn.silu(causal_depthwise_conv(gqkv, conv_w[l]))
        gq, gk, gv = jnp.split(gqkv, 3, axis=-1)
        to_b = lambda t: t.reshape(B, S, GDN_HEADS, GDN_HEAD_DIM).astype(f32)
        gq = l2norm(to_b(gq)) * GDN_HEAD_DIM ** -0.5
        gk = l2norm(to_b(gk))
        log_decay = -jnp.exp(A_log[l].astype(f32)) * jax.nn.softplus(ga.astype(f32) + dt_bias[l].astype(f32))
        beta = jax.nn.sigmoid(gb.astype(f32))
        o_b = gated_delta_rule(gq, gk, to_b(gv), log_decay, beta)
        o_b = rmsnorm(o_b, gdn_norm[l]) * jax.nn.silu(to_b(gz))
        y_b = o_b.reshape(B, S, GDN_WIDTH).astype(x.dtype)
        mix = jnp.concatenate([y_a, y_b], axis=-1)
        x = x + jnp.einsum('bse,ed->bsd', mix, w_out[l])
        h = rmsnorm(x, ffn_norm[l]).reshape(B * S, D)
        y = hierarchical_moe(h, w_group[l], w_router[l], w_gate[l], w_up[l], w_down[l])
        x = x + y.reshape(B, S, D)
    return rmsnorm(x, final_norm)
```

```cpp
#include <hip/hip_runtime.h>
#include <hip/hip_cooperative_groups.h>
#include <cstdio>
#include <cstdint>
namespace cg = cooperative_groups;
namespace pg8 {
#define PG8_LAS __attribute__((address_space(3)))
typedef unsigned short bf16_t;
typedef short bf16x8 __attribute__((ext_vector_type(8)));
typedef float f32x4 __attribute__((ext_vector_type(4)));
typedef unsigned u32x4 __attribute__((ext_vector_type(4)));
constexpr int BM = 256, BK = 64, HALF = 128, HTB = HALF * BK * 2  , STAGE_BYTES = 8 * HTB, NXCD = 8, WGM = 8;

__host__ __device__ __forceinline__ int lds_byte(int r, int c) { const int st = (r >> 4) * 2 + (c >> 5), rr = r & 15, cc = c & 31, ob = rr * 64 + cc * 2; return st * 1024 + (ob ^ (((ob >> 9) & 1) << 5)); }
__host__ __device__ __forceinline__ void stage_rc(int b, int& R, int& C) { const int st = b / 1024, sb = b % 1024, swz = sb ^ (((sb >> 9) & 1) << 5); R = (st >> 1) * 16 + swz / 64; C = (st & 1) * 32 + (swz % 64) / 2; }
__host__ __device__ __forceinline__ int perm32(int rho) { const int n = rho >> 4, i = rho & 15; return 8 * (i >> 2) + 4 * n + (i & 3); }

struct Unit { int pm, pn; };
struct Gemm { const bf16_t* A; const bf16_t* Bt; int lda, K; };

struct StaticOrder {
    int nM, nN, nwg, G, c;
    __host__ __device__ void init(int M, int N, int G_, int c_) { nM = M / BM; nN = N / BM; nwg = nM * nN; G = G_; c = c_; }
    __host__ __device__ bool next(int i, Unit& u) const {
        const long L = (long)i * G + c; if (L >= nwg) return false;
        int wgid = (int)L; { const int q = nwg / NXCD, r = nwg % NXCD, xcd = wgid % NXCD, off = wgid / NXCD; wgid = (xcd < r ? xcd * (q + 1) : r * (q + 1) + (xcd - r) * q) + off; }
        const int nig = WGM * nN, gid = wgid / nig, fm = gid * WGM, gsz = (nM - fm) < WGM ? (nM - fm) : WGM;
        u.pm = fm + ((wgid % nig) % gsz); u.pn = (wgid % nig) / gsz; return true;
    }
    __device__ __forceinline__ void a_ready(const Unit&) const {}
    __device__ __forceinline__ void done(const Unit&) const {}
};

__device__ __forceinline__ unsigned cvt_pk_bf16(float lo, float hi) { unsigned r; asm volatile("v_cvt_pk_bf16_f32 %0, %1, %2" : "=v"(r) : "v"(lo), "v"(hi)); return r; }

struct EpiStoreBf16 {
    static constexpr bool PERM = true, AFTER_DRAIN = false;
    bf16_t* O; int ldc; int scale_cols; float scale0;
    __device__ __forceinline__ void operator()(const f32x4 (&acc)[2][2][4][2], const Unit& u, int wr, int wc, int fr, int fq) const {
        const int row0 = u.pm * BM + wr * 64 + fr; const int colt = u.pn * BM;
        const float sc = (colt < scale_cols) ? scale0 : 1.f;
        const int col0 = colt + wc * 32 + 8 * fq;
#pragma unroll
        for (int ai = 0; ai < 2; ++ai)
#pragma unroll
            for (int m = 0; m < 4; ++m) { bf16_t* rowp = O + (size_t)(row0 + ai * HALF + m * 16) * ldc + col0;
#pragma unroll
                for (int bj = 0; bj < 2; ++bj) { const f32x4 v0 = acc[ai][bj][m][0] * sc, v1 = acc[ai][bj][m][1] * sc;
                    u32x4 w; w.x = cvt_pk_bf16(v0[0], v0[1]); w.y = cvt_pk_bf16(v0[2], v0[3]); w.z = cvt_pk_bf16(v1[0], v1[1]); w.w = cvt_pk_bf16(v1[2], v1[3]);
                    *(u32x4*)(rowp + bj * HALF) = w; } }
    }
};
struct EpiResF32 {
    static constexpr bool PERM = false, AFTER_DRAIN = false;
    const float* base; float* out; int ldc;
    __device__ __forceinline__ void operator()(const f32x4 (&acc)[2][2][4][2], const Unit& u, int wr, int wc, int fr, int fq) const {
        const int row0 = u.pm * BM + wr * 64 + fr, col0 = u.pn * BM + wc * 32 + 4 * fq;
#pragma unroll
        for (int ai = 0; ai < 2; ++ai)
#pragma unroll
            for (int m = 0; m < 4; ++m) { const size_t off = (size_t)(row0 + ai * HALF + m * 16) * ldc + col0;
#pragma unroll
                for (int bj = 0; bj < 2; ++bj)
#pragma unroll
                    for (int n = 0; n < 2; ++n) { const f32x4 b = *(const f32x4*)(base + off + bj * HALF + n * 16); *(f32x4*)(out + off + bj * HALF + n * 16) = b + acc[ai][bj][m][n]; } }
    }
};
struct EpiGateUp {
    static constexpr bool PERM = true, AFTER_DRAIN = false;
    bf16_t* hid; const float* roww;
    __device__ __forceinline__ void operator()(const f32x4 (&acc)[2][2][4][2], const Unit& u, int wr, int wc, int fr, int fq) const {
        const int row0 = u.pm * BM + wr * 64 + fr; const int hc0 = (u.pn & 1) * 128 + 16 * wc + 4 * fq;
#pragma unroll
        for (int ai = 0; ai < 2; ++ai)
#pragma unroll
            for (int m = 0; m < 4; ++m) { const int r = row0 + ai * HALF + m * 16; const float w = roww[r]; bf16_t* rowp = hid + (size_t)r * 256 + hc0;
#pragma unroll
                for (int bj = 0; bj < 2; ++bj) { const f32x4 v0 = acc[ai][bj][m][0], v1 = acc[ai][bj][m][1];
                    const float h0 = v0[0] / (1.f + __expf(-v0[0])) * v0[1] * w, h1 = v0[2] / (1.f + __expf(-v0[2])) * v0[3] * w;
                    const float h2 = v1[0] / (1.f + __expf(-v1[0])) * v1[1] * w, h3 = v1[2] / (1.f + __expf(-v1[2])) * v1[3] * w;
                    uint2 o; o.x = cvt_pk_bf16(h0, h1); o.y = cvt_pk_bf16(h2, h3);
                    *(uint2*)(rowp + bj * 64) = o; } }
    }
};
struct EpiDown {
    static constexpr bool PERM = true, AFTER_DRAIN = false;
    bf16_t* y2; const int* rowmap;
    __device__ __forceinline__ void operator()(const f32x4 (&acc)[2][2][4][2], const Unit& u, int wr, int wc, int fr, int fq) const {
        const int row0 = u.pm * BM + wr * 64 + fr; const int col0 = (u.pn & 3) * 256 + wc * 32 + 8 * fq;
#pragma unroll
        for (int ai = 0; ai < 2; ++ai)
#pragma unroll
            for (int m = 0; m < 4; ++m) { int r = row0 + ai * HALF + m * 16; asm volatile("" : "+v"(r)); const int dst = rowmap[r];
                bf16_t* rowp = y2 + (size_t)dst * 1024 + col0;
#pragma unroll
                for (int bj = 0; bj < 2; ++bj) { const f32x4 v0 = acc[ai][bj][m][0], v1 = acc[ai][bj][m][1];
                    u32x4 w; w.x = cvt_pk_bf16(v0[0], v0[1]); w.y = cvt_pk_bf16(v0[2], v0[3]); w.z = cvt_pk_bf16(v1[0], v1[1]); w.w = cvt_pk_bf16(v1[2], v1[3]);
                    *(u32x4*)(rowp + bj * HALF) = w; } }
    }
};
struct MoeOrder {
    const int* tile_e; int ntiles, nsub, G, c;
    __device__ __forceinline__ bool next(int i, Unit& u) const {
        const int L = i * G + c; if (L >= ntiles * nsub) return false;
        const int mt = L / nsub, j = L - mt * nsub; u.pm = mt; u.pn = tile_e[mt] * nsub + j; return true;
    }
    __device__ __forceinline__ void a_ready(const Unit&) const {}
    __device__ __forceinline__ void done(const Unit&) const {}
};

template <class Epi, class Sched, bool ALIGN_EPI = false, bool SP2 = false>
__device__ __forceinline__ void gemm_phase(PG8_LAS unsigned char* lds, const Gemm g, const Sched& S, const Epi& E, const int wid) {
    const int lane = (int)__builtin_amdgcn_mbcnt_hi(~0u, __builtin_amdgcn_mbcnt_lo(~0u, 0u)), tid = wid * 64 + lane, wr = wid >> 2, wc = wid & 3, fr = lane & 15, fq = lane >> 4;
    const int K = g.K, nt = K / BK, lda = g.lda;
    unsigned voffA[2], voffB[2];
#pragma unroll
    for (int i = 0; i < 2; ++i) { int R, C; stage_rc(tid * 16 + i * 8192, R, C); const int Rb = Epi::PERM ? ((R & ~31) + perm32(R & 31)) : R;
        voffA[i] = (unsigned)(R * lda + C) * 2u; voffB[i] = (unsigned)(Rb * K + C) * 2u; }
    const size_t kstep = (size_t)(BK * 2);
    const size_t hstepA = (size_t)HALF * lda * 2, hstepB = (size_t)HALF * K * 2;
    const size_t tstepA = 2 * hstepA, tstepB = 2 * hstepB;
    const unsigned ldsw = (unsigned)wid * 1024u;
    const int aoff = lds_byte(wr * 64 + fr, fq * 8), boff = lds_byte(wc * 32 + fr, fq * 8);
#define PG8_SA(b, h) (((b) * 2 + (h)) * HTB)
#define PG8_SB(b, h) ((4 + (b) * 2 + (h)) * HTB)
#define PG8_STAGE(bufoff, gbase, voff) do { _Pragma("unroll") for (int _i = 0; _i < 2; ++_i) \
        __builtin_amdgcn_global_load_lds((const unsigned*)((const char*)(gbase) + (voff)[_i]), (PG8_LAS unsigned*)(lds + (bufoff) + ldsw + _i * 8192), 16, 0, 0); } while (0)
#define PG8_LDA(dst, b, h) do { _Pragma("unroll") for (int m = 0; m < 4; ++m) _Pragma("unroll") for (int k = 0; k < 2; ++k) dst[m][k] = *(const PG8_LAS bf16x8*)(lds + PG8_SA(b, h) + aoff + m * 2048 + k * 1024); } while (0)
#define PG8_LDB(dst, b, h) do { _Pragma("unroll") for (int n = 0; n < 2; ++n) _Pragma("unroll") for (int k = 0; k < 2; ++k) dst[n][k] = *(const PG8_LAS bf16x8*)(lds + PG8_SB(b, h) + boff + n * 2048 + k * 1024); } while (0)
#define PG8_MMA(ai, bj, At, Bt) do { __builtin_amdgcn_s_setprio(1); _Pragma("unroll") for (int m = 0; m < 4; ++m) _Pragma("unroll") for (int n = 0; n < 2; ++n) _Pragma("unroll") for (int k = 0; k < 2; ++k) \
        acc[ai][bj][m][n] = __builtin_amdgcn_mfma_f32_16x16x32_bf16(Bt[n][k], At[m][k], acc[ai][bj][m][n], 0, 0, 0); __builtin_amdgcn_s_setprio(0); } while (0)
#define PG8_WAIT_V(n) asm volatile("s_waitcnt vmcnt(" #n ")" ::: "memory")
#define PG8_WAIT_L(n) asm volatile("s_waitcnt lgkmcnt(" #n ")" ::: "memory")
#define PG8_BAR __builtin_amdgcn_s_barrier()
#define PG8_SCHED __builtin_amdgcn_sched_barrier(0)
    Unit cur, nxt; int ui = 0;
    if (!S.next(0, cur)) return;
    f32x4 acc[2][2][4][2];
#pragma unroll
    for (int a = 0; a < 2; ++a)
#pragma unroll
        for (int b = 0; b < 2; ++b)
#pragma unroll
            for (int m = 0; m < 4; ++m)
#pragma unroll
                for (int n = 0; n < 2; ++n) acc[a][b][m][n] = (f32x4){0.f, 0.f, 0.f, 0.f};
    bf16x8 At[4][2], B0[2][2], B1[2][2];
    const char* cA = (const char*)g.A + (size_t)cur.pm * tstepA; const char* cB = (const char*)g.Bt + (size_t)cur.pn * tstepB;
    S.a_ready(cur);
    if constexpr (SP2) {
        PG8_STAGE(PG8_SB(0, 0), cB, voffB); PG8_STAGE(PG8_SB(0, 1), cB + hstepB, voffB); PG8_STAGE(PG8_SA(0, 0), cA, voffA); PG8_STAGE(PG8_SA(0, 1), cA + hstepA, voffA);
        if (wr == 1) PG8_BAR;
        PG8_WAIT_V(2); PG8_BAR;
        PG8_STAGE(PG8_SB(1, 0), cB + kstep, voffB); PG8_STAGE(PG8_SA(1, 0), cA + kstep, voffA); PG8_STAGE(PG8_SB(1, 1), cB + hstepB + kstep, voffB);
        PG8_WAIT_V(6); PG8_BAR;
    } else {
        PG8_STAGE(PG8_SB(0, 0), cB, voffB); PG8_STAGE(PG8_SA(0, 0), cA, voffA); PG8_STAGE(PG8_SB(0, 1), cB + hstepB, voffB); PG8_STAGE(PG8_SA(0, 1), cA + hstepA, voffA);
        if (wr == 1) PG8_BAR;
        PG8_WAIT_V(4); PG8_BAR;
        PG8_STAGE(PG8_SB(1, 0), cB + kstep, voffB); PG8_STAGE(PG8_SA(1, 0), cA + kstep, voffA); PG8_STAGE(PG8_SB(1, 1), cB + hstepB + kstep, voffB);
        PG8_WAIT_V(6); PG8_BAR;
    }
    for (;;) {
        const bool has_next = S.next(ui + 1, nxt);
        const char* nA = has_next ? (const char*)g.A + (size_t)nxt.pm * tstepA : cA; const char* nB = has_next ? (const char*)g.Bt + (size_t)nxt.pn * tstepB : cB;
        for (int t = 0; t < nt; t += 2) {
            const bool last = (t == nt - 2);
            const char* a1 = cA + (size_t)(t + 1) * kstep;
            const char* a2 = last ? nA : cA + (size_t)(t + 2) * kstep; const char* b2 = last ? nB : cB + (size_t)(t + 2) * kstep;
            const char* a3 = a2 + kstep; const char* b3 = b2 + kstep;
            if (last && has_next) S.a_ready(nxt);
            if constexpr (SP2) {
            PG8_LDB(B0, 0, 0); PG8_LDB(B1, 0, 1); PG8_SCHED; PG8_LDA(At, 0, 0); PG8_STAGE(PG8_SA(1, 1), a1 + hstepA, voffA);
            PG8_WAIT_V(8); PG8_WAIT_L(0); PG8_BAR; PG8_MMA(0, 0, At, B0); PG8_MMA(0, 1, At, B1); PG8_BAR; PG8_SCHED;
            PG8_LDA(At, 0, 1); PG8_STAGE(PG8_SB(0, 0), b2, voffB); PG8_STAGE(PG8_SB(0, 1), b2 + hstepB, voffB); PG8_STAGE(PG8_SA(0, 0), a2, voffA);
            PG8_WAIT_V(8); PG8_WAIT_L(0); PG8_BAR; PG8_MMA(1, 0, At, B0); PG8_MMA(1, 1, At, B1); PG8_BAR; PG8_SCHED;
            PG8_LDB(B0, 1, 0); PG8_LDB(B1, 1, 1); PG8_SCHED; PG8_LDA(At, 1, 0); PG8_STAGE(PG8_SA(0, 1), a2 + hstepA, voffA);
            PG8_WAIT_V(8); PG8_WAIT_L(0); PG8_BAR; PG8_MMA(0, 0, At, B0); PG8_MMA(0, 1, At, B1); PG8_BAR; PG8_SCHED;
            PG8_LDA(At, 1, 1); PG8_STAGE(PG8_SB(1, 0), b3, voffB); PG8_STAGE(PG8_SB(1, 1), b3 + hstepB, voffB); PG8_STAGE(PG8_SA(1, 0), a3, voffA);
            PG8_WAIT_V(8); PG8_WAIT_L(0); PG8_BAR; PG8_MMA(1, 0, At, B0); PG8_MMA(1, 1, At, B1); PG8_BAR; PG8_SCHED;
            } else {
            PG8_LDB(B0, 0, 0); PG8_SCHED; PG8_LDA(At, 0, 0); PG8_STAGE(PG8_SA(1, 1), a1 + hstepA, voffA);
            PG8_WAIT_L(8); PG8_BAR; PG8_WAIT_L(0); PG8_MMA(0, 0, At, B0); PG8_BAR; PG8_SCHED;
            PG8_LDB(B1, 0, 1); PG8_STAGE(PG8_SB(0, 0), b2, voffB);
            PG8_BAR; PG8_WAIT_L(0); PG8_MMA(0, 1, At, B1); PG8_BAR;
            PG8_LDA(At, 0, 1); PG8_STAGE(PG8_SA(0, 0), a2, voffA);
            PG8_BAR; PG8_WAIT_L(0); PG8_MMA(1, 0, At, B0); PG8_BAR; PG8_SCHED;
            PG8_STAGE(PG8_SB(0, 1), b2 + hstepB, voffB);
            PG8_WAIT_V(6); PG8_BAR; PG8_MMA(1, 1, At, B1); PG8_BAR;
            PG8_LDB(B0, 1, 0); PG8_SCHED; PG8_LDA(At, 1, 0); PG8_STAGE(PG8_SA(0, 1), a2 + hstepA, voffA);
            PG8_WAIT_L(8); PG8_BAR; PG8_WAIT_L(0); PG8_MMA(0, 0, At, B0); PG8_BAR; PG8_SCHED;
            PG8_LDB(B1, 1, 1); PG8_STAGE(PG8_SB(1, 0), b3, voffB);
            PG8_BAR; PG8_WAIT_L(0); PG8_MMA(0, 1, At, B1); PG8_BAR;
            PG8_LDA(At, 1, 1); PG8_STAGE(PG8_SA(1, 0), a3, voffA);
            PG8_BAR; PG8_WAIT_L(0); PG8_MMA(1, 0, At, B0); PG8_BAR; PG8_SCHED;
            PG8_STAGE(PG8_SB(1, 1), b3 + hstepB, voffB);
            PG8_WAIT_V(6); PG8_BAR; PG8_MMA(1, 1, At, B1); PG8_BAR;
            }
        }
        if constexpr (ALIGN_EPI) { if (wr == 0) PG8_BAR; }
        if constexpr (!Epi::AFTER_DRAIN) { E(acc, cur, wr, wc, fr, fq); S.done(cur); }
        if (!has_next) break;
#pragma unroll
        for (int a = 0; a < 2; ++a)
#pragma unroll
            for (int b = 0; b < 2; ++b)
#pragma unroll
                for (int m = 0; m < 4; ++m)
#pragma unroll
                    for (int n = 0; n < 2; ++n) acc[a][b][m][n] = (f32x4){0.f, 0.f, 0.f, 0.f};
        cur = nxt; cA = nA; cB = nB; ++ui;
        if constexpr (ALIGN_EPI) { if (wr == 1) PG8_BAR; }
    }
    PG8_WAIT_V(0);
    if constexpr (!ALIGN_EPI) { if (wr == 0) PG8_BAR; }
    PG8_BAR;
    if constexpr (Epi::AFTER_DRAIN) { E.fused(acc, cur, wr, wc, fr, fq, lds, wid, lane); S.done(cur); }
#undef PG8_SA
#undef PG8_SB
#undef PG8_STAGE
#undef PG8_LDA
#undef PG8_LDB
#undef PG8_MMA
#undef PG8_WAIT_V
#undef PG8_WAIT_L
#undef PG8_BAR
#undef PG8_SCHED
}
}

#define GAS __attribute__((address_space(1)))
#define LAS __attribute__((address_space(3)))
typedef unsigned short bf16;
typedef unsigned v4u __attribute__((ext_vector_type(4)));
typedef float f32x4 __attribute__((ext_vector_type(4)));

constexpr int NWAVES = 8, NTHREADS = NWAVES * 64;
constexpr int NB = 16, NS = 2048, T = NB * NS, D = 1024;
constexpr int NP = 3584;
constexpr int PC_MQ = 0, PC_GZ = 512, PC_MK = 1024, PC_MV = 1536, PC_GQ = 2048, PC_GK = 2560, PC_GV = 3072;
constexpr int WIN_LD = 3592;
constexpr int MH = 8, MD = 64, MBLK = 256, MNB = NS / MBLK;
constexpr int GH = 4, GD = 128;
constexpr int NE = 32, FF = 256;
constexpr int MAXTILES = 288, MAXROWS = MAXTILES * 256;
constexpr float RMS_EPS = 1e-6f;

constexpr size_t MiB = 1u << 20;
constexpr size_t WS_CTL = 0, CTL_ZERO_BYTES = 1 * MiB;
constexpr size_t WS_WIN = 1 * MiB, WS_WOUT = 8 * MiB, WS_WGU = 10 * MiB, WS_WD = 42 * MiB;
constexpr size_t WS_GAB = 58 * MiB, WS_KMEAN = 59 * MiB;
constexpr size_t WS_TOKE = 60 * MiB, WS_TOKW = WS_TOKE + 256 * 1024, WS_TOKR = WS_TOKW + 256 * 1024, WS_ROWMAP = WS_TOKR + 256 * 1024, WS_ROWW = WS_ROWMAP + 512 * 1024, WS_TILEE = WS_ROWW + 512 * 1024;
constexpr size_t WS_HB = 64 * MiB;
constexpr size_t WS_P = 128 * MiB;
constexpr size_t WS_XS = WS_P;
constexpr size_t WS_HID = WS_P + 144 * MiB;
constexpr size_t WS_Y2 = 352 * MiB;
constexpr size_t WS_END = 481 * MiB;
static_assert(WS_TILEE + 4096 <= WS_HB && WS_HID + (size_t)MAXROWS * 256 * 2 <= WS_Y2 && WS_P + (size_t)T * NP * 2 <= WS_Y2, "ws map");
constexpr int CW_CNT = 64;
constexpr int CW_NT = 128;

constexpr int LDS_BYTES = 155648;

__device__ __forceinline__ unsigned f2bf(float f) { unsigned u = __builtin_bit_cast(unsigned, f); return (u + 0x7fffu + ((u >> 16) & 1u)) >> 16; }
__device__ __forceinline__ unsigned pk2(float lo, float hi) { return f2bf(lo) | (f2bf(hi) << 16); }
__device__ __forceinline__ float bflo(unsigned u) { return __builtin_bit_cast(float, u << 16); }
__device__ __forceinline__ float bfhi(unsigned u) { return __builtin_bit_cast(float, u & 0xffff0000u); }
__device__ __forceinline__ float bf2f(bf16 h) { return __builtin_bit_cast(float, (unsigned)h << 16); }
__device__ __forceinline__ float wave_sum(float v) {
#pragma unroll
    for (int o = 1; o < 64; o <<= 1) v += __shfl_xor(v, o);
    return v;
}
__device__ __forceinline__ float siluf(float x) { return x / (1.f + __expf(-x)); }

struct Args {
    const float* x; const float* attn_norm; const float* w_in; const float* conv_w; const float* A_log; const float* dt_bias; const float* gdn_norm; const float* w_out;
    const float* ffn_norm; const float* w_group; const float* w_router; const float* w_gate; const float* w_up; const float* w_down; const float* final_norm;
    float* out; unsigned char* ws; int ph_lo, ph_hi;
};

struct Ctx {
    LAS unsigned char* lds; int wave, G, bid;
};
__device__ __forceinline__ int lane_id() { return (int)__builtin_amdgcn_mbcnt_hi(~0u, __builtin_amdgcn_mbcnt_lo(~0u, 0u)); }
#define LANE_TID const int lane = lane_id(), tid = F.wave * 64 + lane; (void)tid; (void)lane

__device__ __forceinline__ void tr_item(const float* W, int ldn, int ncol0, int K, int nblk, bf16* WT, int row_off, int rmul, LAS float* scr, int item, int lane) {
    const int kb = item / nblk, nb = item - kb * nblk, k0 = 64 * kb, n0 = 32 * nb;
#pragma unroll 8
    for (int i = 0; i < 32; ++i) { const int kk = 2 * i + (lane >> 5); scr[kk * 33 + (lane & 31)] = W[(size_t)(k0 + kk) * ldn + ncol0 + n0 + (lane & 31)]; }
    asm volatile("s_waitcnt lgkmcnt(0)" ::: "memory");
    const int c = lane & 7;
#pragma unroll
    for (int j = 0; j < 4; ++j) { const int n = (lane >> 3) + 8 * j; const LAS float* s = scr + (8 * c) * 33 + n;
        v4u o; o.x = pk2(s[0 * 33], s[1 * 33]); o.y = pk2(s[2 * 33], s[3 * 33]); o.z = pk2(s[4 * 33], s[5 * 33]); o.w = pk2(s[6 * 33], s[7 * 33]);
        *(v4u*)(WT + (size_t)(row_off + rmul * (n0 + n)) * K + k0 + 8 * c) = o; }
    asm volatile("s_waitcnt lgkmcnt(0)" ::: "memory");
}

__device__ __forceinline__ void p0_prologue(const Args& a, const Ctx& F) {
    LANE_TID;
    unsigned char* ws = a.ws;
    bf16* Win_t = (bf16*)(ws + WS_WIN); bf16* Wout_t = (bf16*)(ws + WS_WOUT); bf16* Wgu_t = (bf16*)(ws + WS_WGU); bf16* Wd_t = (bf16*)(ws + WS_WD);
    LAS float* scr = (LAS float*)(F.lds + F.wave * 8704);
    const int gw = F.bid * NWAVES + F.wave, NGW = F.G * NWAVES;
    constexpr int I_S = 16 * 16;
    constexpr int I_IN = 16 * 112, I_OUT = 16 * 32, I_G = 16 * 8, I_D = 4 * 32;
    constexpr int NITEMS = I_IN + I_OUT + NE * I_G * 2 + NE * I_D;
    for (int it = gw; it < NITEMS; it += NGW) {
        int r = it;
        if (r < I_IN) {
            if (r < I_S)      { tr_item(a.w_in, WIN_LD, 0,    1024, 16, Win_t, PC_MQ, 1, scr, r, lane); continue; } r -= I_S;
            if (r < I_S)      { tr_item(a.w_in, WIN_LD, 3072, 1024, 16, Win_t, PC_GZ, 1, scr, r, lane); continue; } r -= I_S;
            if (r < I_S)      { tr_item(a.w_in, WIN_LD, 512,  1024, 16, Win_t, PC_MK, 1, scr, r, lane); continue; } r -= I_S;
            if (r < I_S)      { tr_item(a.w_in, WIN_LD, 1024, 1024, 16, Win_t, PC_MV, 1, scr, r, lane); continue; } r -= I_S;
            tr_item(a.w_in, WIN_LD, 1536, 1024, 48, Win_t, PC_GQ, 1, scr, r, lane); continue;
        }
        r -= I_IN;
        if (r < I_OUT) { tr_item(a.w_out, 1024, 0, 1024, 32, Wout_t, 0, 1, scr, r, lane); continue; }
        r -= I_OUT;
        if (r < NE * I_G * 2) { const int e = r / (2 * I_G), q = r - e * 2 * I_G, s = q / I_G, ii = q - s * I_G;
            tr_item((s ? a.w_up : a.w_gate) + (size_t)e * 1024 * 256, 256, 0, 1024, 8, Wgu_t, e * 512 + s, 2, scr, ii, lane); continue; }
        r -= NE * I_G * 2;
        { const int e = r / I_D, ii = r - e * I_D; tr_item(a.w_down + (size_t)e * 256 * 1024, 1024, 0, 256, 32, Wd_t, e * 1024, 1, scr, ii, lane); }
    }
    LAS float* W8t = (LAS float*)(F.lds + 73728);
    for (int idx = tid; idx < 8192; idx += NTHREADS) { const int k = idx >> 3, o = idx & 7; W8t[o * 1024 + k] = a.attn_norm[k] * a.w_in[(size_t)k * WIN_LD + 3584 + o]; }
    __syncthreads();
    bf16* hb = (bf16*)(ws + WS_HB); float* gab = (float*)(ws + WS_GAB);
    f32x4 gn[4];
#pragma unroll
    for (int j = 0; j < 4; ++j) gn[j] = ((const f32x4*)a.attn_norm)[64 * j + lane];
    for (int m = gw; m < T; m += NGW) {
        const f32x4* xr = (const f32x4*)(a.x + (size_t)m * D) + lane;
        f32x4 v[4]; float s = 0.f;
#pragma unroll
        for (int j = 0; j < 4; ++j) { v[j] = xr[64 * j]; s += (v[j].x * v[j].x + v[j].y * v[j].y) + (v[j].z * v[j].z + v[j].w * v[j].w); }
        const float rs = 1.0f / sqrtf(wave_sum(s) * (1.f / D) + RMS_EPS);
        uint2* o8 = (uint2*)(hb + (size_t)m * D) + lane;
#pragma unroll
        for (int j = 0; j < 4; ++j) { uint2 o; o.x = pk2(v[j].x * rs * gn[j].x, v[j].y * rs * gn[j].y); o.y = pk2(v[j].z * rs * gn[j].z, v[j].w * rs * gn[j].w); o8[64 * j] = o; }
        float myv = 0.f;
#pragma unroll
        for (int o = 0; o < 8; ++o) { float acc = 0.f;
#pragma unroll
            for (int j = 0; j < 4; ++j) { const f32x4 w = *(const LAS f32x4*)(W8t + o * 1024 + 256 * j + 4 * lane); acc += (v[j].x * w.x + v[j].y * w.y) + (v[j].z * w.z + v[j].w * w.w); }
            acc = wave_sum(acc) * rs; if (lane == o) myv = acc; }
        if (lane < 8) gab[(size_t)m * 8 + lane] = myv;
    }
}

__device__ __forceinline__ void p2_kmean(const Args& a, const Ctx& F) {
    LANE_TID;
    const bf16* P = (const bf16*)(a.ws + WS_P); float* kmean = (float*)(a.ws + WS_KMEAN);
    const int gw = F.bid * NWAVES + F.wave, NGW = F.G * NWAVES;
    for (int it = gw; it < NB * MH * MNB; it += NGW) {
        const int blk = it % MNB, h = (it / MNB) % MH, b = it / (MNB * MH);
        const bf16* kp = P + (size_t)(b * NS + blk * MBLK) * NP + PC_MK + h * MD + lane;
        float s = 0.f;
#pragma unroll 8
        for (int r = 0; r < MBLK; ++r) s += bf2f(kp[(size_t)r * NP]);
        kmean[(size_t)it * MD + lane] = s * (1.f / MBLK);
    }
}

__device__ __forceinline__ void p3_attn_naive(const Args& a, const Ctx& F) {
    LANE_TID;
    bf16* P = (bf16*)(a.ws + WS_P); const float* kmean = (const float*)(a.ws + WS_KMEAN);
    const int gw = F.bid * NWAVES + F.wave, NGW = F.G * NWAVES;
    for (int u = gw; u < NB * MH * (NS / 64); u += NGW) {
        const int qt = u % (NS / 64), h = (u / (NS / 64)) % MH, b = u / ((NS / 64) * MH);
        const int own = qt >> 2, t = qt * 64 + lane;
        const size_t rowbase = (size_t)b * NS;
        bf16* qp = P + (rowbase + t) * NP + PC_MQ + h * MD;
        unsigned qk[32];
#pragma unroll
        for (int i = 0; i < 8; ++i) { const v4u w = ((const v4u*)qp)[i]; qk[4 * i] = w.x; qk[4 * i + 1] = w.y; qk[4 * i + 2] = w.z; qk[4 * i + 3] = w.w; }
        float gate[7];
#pragma unroll
        for (int j = 0; j < 7; ++j) { gate[j] = -INFINITY;
            if (j < own) { const float* km = kmean + ((size_t)((b * MH + h) * MNB + j)) * MD; float s = 0.f;
#pragma unroll
                for (int d = 0; d < 32; ++d) s += bflo(qk[d]) * km[2 * d] + bfhi(qk[d]) * km[2 * d + 1];
                gate[j] = s; } }
        unsigned mask = 0u;
        if (own <= 3) mask = (1u << own) - 1u;
        else {
#pragma unroll
            for (int r = 0; r < 3; ++r) { int best = 0; float bv = -INFINITY;
#pragma unroll
                for (int j = 0; j < 7; ++j) { const bool ok = (j < own) && !((mask >> j) & 1u) && (gate[j] > bv); if (ok) { bv = gate[j]; best = j; } }
                mask |= 1u << best; }
        }
        float o[64];
#pragma unroll
        for (int d = 0; d < 64; ++d) o[d] = 0.f;
        float mrun = -1e30f, lrun = 0.f;
        const bf16* Kb = P + rowbase * NP + PC_MK + h * MD; const bf16* Vb = P + rowbase * NP + PC_MV + h * MD;
        for (int j = 0; j <= own; ++j) {
            const bool isown = (j == own);
            const bool sel = isown || ((mask >> j) & 1u);
            if (__ballot(sel) == 0ull) continue;
            const int nk = isown ? ((qt & 3) * 64 + 64) : MBLK;
#pragma unroll 1
            for (int kk = 0; kk < nk; ++kk) {
                const int key = j * MBLK + kk; const v4u* kp = (const v4u*)(Kb + (size_t)key * NP); float acc = 0.f;
#pragma unroll
                for (int c = 0; c < 8; ++c) { const v4u w = kp[c];
                    acc += bflo(qk[4 * c]) * bflo(w.x) + bfhi(qk[4 * c]) * bfhi(w.x) + bflo(qk[4 * c + 1]) * bflo(w.y) + bfhi(qk[4 * c + 1]) * bfhi(w.y)
                         + bflo(qk[4 * c + 2]) * bflo(w.z) + bfhi(qk[4 * c + 2]) * bfhi(w.z) + bflo(qk[4 * c + 3]) * bflo(w.w) + bfhi(qk[4 * c + 3]) * bfhi(w.w); }
                const bool valid = sel && (!isown || key <= t);
                const float sc = valid ? acc * 0.125f : -1e30f;
                const float mnew = fmaxf(mrun, sc), alpha = __expf(mrun - mnew);
                const float p = valid ? __expf(sc - mnew) : 0.f;
                lrun = lrun * alpha + p; mrun = mnew;
                const v4u* vp = (const v4u*)(Vb + (size_t)key * NP);
#pragma unroll
                for (int c = 0; c < 8; ++c) { const v4u w = vp[c];
                    o[8 * c + 0] = o[8 * c + 0] * alpha + p * bflo(w.x); o[8 * c + 1] = o[8 * c + 1] * alpha + p * bfhi(w.x); o[8 * c + 2] = o[8 * c + 2] * alpha + p * bflo(w.y); o[8 * c + 3] = o[8 * c + 3] * alpha + p * bfhi(w.y);
                    o[8 * c + 4] = o[8 * c + 4] * alpha + p * bflo(w.z); o[8 * c + 5] = o[8 * c + 5] * alpha + p * bfhi(w.z); o[8 * c + 6] = o[8 * c + 6] * alpha + p * bflo(w.w); o[8 * c + 7] = o[8 * c + 7] * alpha + p * bfhi(w.w); }
            }
        }
        const float inv = 1.f / lrun;
#pragma unroll
        for (int i = 0; i < 8; ++i) { v4u w; w.x = pk2(o[8 * i] * inv, o[8 * i + 1] * inv); w.y = pk2(o[8 * i + 2] * inv, o[8 * i + 3] * inv); w.z = pk2(o[8 * i + 4] * inv, o[8 * i + 5] * inv); w.w = pk2(o[8 * i + 6] * inv, o[8 * i + 7] * inv);
            ((v4u*)qp)[i] = w; }
    }
}

__device__ __forceinline__ void p3_gdn_naive(const Args& a, const Ctx& F) {
    LANE_TID;
    bf16* P = (bf16*)(a.ws + WS_P); const float* gab = (const float*)(a.ws + WS_GAB);
    LAS float* red = (LAS float*)(F.lds);
    LAS float* red2 = red + 16;
    LAS float* qs = red + 32;
    LAS float* ks = qs + 512;
    const int h = tid >> 7, c = tid & 127, wv = (tid >> 6) & 1;
    for (int b = F.bid; b < NB; b += F.G) {
        float S[128];
#pragma unroll
        for (int k = 0; k < 128; ++k) S[k] = 0.f;
        float xq0 = 0.f, xq1 = 0.f, xq2 = 0.f, xk0 = 0.f, xk1 = 0.f, xk2 = 0.f, xv0 = 0.f, xv1 = 0.f, xv2 = 0.f;
        float cq[4], ck[4], cv[4];
#pragma unroll
        for (int i = 0; i < 4; ++i) { cq[i] = a.conv_w[i * 1536 + h * 128 + c]; ck[i] = a.conv_w[i * 1536 + 512 + h * 128 + c]; cv[i] = a.conv_w[i * 1536 + 1024 + h * 128 + c]; }
        const float negA = -__expf(a.A_log[h]), dtb = a.dt_bias[h], gnorm = a.gdn_norm[c];
        for (int t = 0; t < NS; ++t) {
            const size_t row = (size_t)b * NS + t;
            bf16* pr = P + row * NP;
            const float xq3 = bf2f(pr[PC_GQ + h * 128 + c]), xk3 = bf2f(pr[PC_GK + h * 128 + c]), xv3 = bf2f(pr[PC_GV + h * 128 + c]);
            const float gz = bf2f(pr[PC_GZ + h * 128 + c]);
            const float ga = gab[row * 8 + h], gb = gab[row * 8 + 4 + h];
            const float qv = siluf(cq[0] * xq0 + cq[1] * xq1 + cq[2] * xq2 + cq[3] * xq3);
            const float kv = siluf(ck[0] * xk0 + ck[1] * xk1 + ck[2] * xk2 + ck[3] * xk3);
            const float vv = siluf(cv[0] * xv0 + cv[1] * xv1 + cv[2] * xv2 + cv[3] * xv3);
            xq0 = xq1; xq1 = xq2; xq2 = xq3; xk0 = xk1; xk1 = xk2; xk2 = xk3; xv0 = xv1; xv1 = xv2; xv2 = xv3;
            const float sq = wave_sum(qv * qv), sk = wave_sum(kv * kv);
            if (lane == 0) { red[(h * 2 + wv) * 2 + 0] = sq; red[(h * 2 + wv) * 2 + 1] = sk; }
            __syncthreads();
            const float ssq = red[(h * 2 + 0) * 2 + 0] + red[(h * 2 + 1) * 2 + 0], ssk = red[(h * 2 + 0) * 2 + 1] + red[(h * 2 + 1) * 2 + 1];
            const float nq = (1.0f / sqrtf(ssq + 1e-6f)) * 0.08838834764831845f, nk = 1.0f / sqrtf(ssk + 1e-6f);
            qs[h * 128 + c] = qv * nq; ks[h * 128 + c] = kv * nk;
            __syncthreads();
            const float xsp = ga + dtb; const float sp = xsp > 20.f ? xsp : log1pf(__expf(xsp));
            const float g = negA * sp, ea = __expf(g), beta = 1.f / (1.f + __expf(-gb));
            float kTS = 0.f;
#pragma unroll
            for (int k4 = 0; k4 < 32; ++k4) { const f32x4 kk = *(const LAS f32x4*)(ks + h * 128 + 4 * k4);
                kTS += kk.x * S[4 * k4] + kk.y * S[4 * k4 + 1] + kk.z * S[4 * k4 + 2] + kk.w * S[4 * k4 + 3];
                if ((k4 & 3) == 3) asm volatile("" ::: "memory"); }
            const float uu = beta * (vv - ea * kTS);
            float ov = 0.f;
#pragma unroll
            for (int k4 = 0; k4 < 32; ++k4) { const f32x4 kk = *(const LAS f32x4*)(ks + h * 128 + 4 * k4); const f32x4 qq = *(const LAS f32x4*)(qs + h * 128 + 4 * k4);
                S[4 * k4] = ea * S[4 * k4] + kk.x * uu; ov += qq.x * S[4 * k4];
                S[4 * k4 + 1] = ea * S[4 * k4 + 1] + kk.y * uu; ov += qq.y * S[4 * k4 + 1];
                S[4 * k4 + 2] = ea * S[4 * k4 + 2] + kk.z * uu; ov += qq.z * S[4 * k4 + 2];
                S[4 * k4 + 3] = ea * S[4 * k4 + 3] + kk.w * uu; ov += qq.w * S[4 * k4 + 3];
                if ((k4 & 3) == 3) asm volatile("" ::: "memory"); }
            const float so = wave_sum(ov * ov);
            if (lane == 0) red2[h * 2 + wv] = so;
            __syncthreads();
            const float rso = 1.0f / sqrtf((red2[h * 2] + red2[h * 2 + 1]) * (1.f / 128.f) + RMS_EPS);
            const float y = ov * rso * gnorm * siluf(gz);
            pr[PC_GZ + h * 128 + c] = (bf16)f2bf(y);
        }
        __syncthreads();
    }
}

__device__ __forceinline__ void p5_router(const Args& a, const Ctx& F) {
    LANE_TID;
    unsigned char* ws = a.ws;
    const float* x1 = a.out; bf16* hb = (bf16*)(ws + WS_HB);
    int* tok_e = (int*)(ws + WS_TOKE); float* tok_w = (float*)(ws + WS_TOKW); int* tok_r = (int*)(ws + WS_TOKR);
    unsigned* gcnt = (unsigned*)(ws + WS_CTL) + CW_CNT;
    LAS float* Wr = (LAS float*)(F.lds);
    LAS int* l_e = (LAS int*)(F.lds + 147456);
    LAS int* l_rank = l_e + 256;
    LAS float* l_w = (LAS float*)(l_rank + 256);
    LAS unsigned* lcnt = (LAS unsigned*)(l_w + 256);
    LAS unsigned* gbase = lcnt + 32;
    for (int idx = tid; idx < 4096; idx += NTHREADS) { const int k = idx >> 2, g = idx & 3; Wr[g * 1024 + k] = a.ffn_norm[k] * a.w_group[idx]; }
    for (int idx = tid; idx < 32768; idx += NTHREADS) { const int k = idx >> 5, e = idx & 31; Wr[(4 + e) * 1024 + k] = a.ffn_norm[k] * a.w_router[idx]; }
    f32x4 gn[4];
#pragma unroll
    for (int j = 0; j < 4; ++j) gn[j] = ((const f32x4*)a.ffn_norm)[64 * j + lane];
    for (int chunk = F.bid; chunk < T / 128; chunk += F.G) {
        if (tid < 32) lcnt[tid] = 0u;
        __syncthreads();
        for (int i = 0; i < 16; ++i) {
            const int lr = F.wave * 16 + i, m = chunk * 128 + lr;
            const f32x4* xr = (const f32x4*)(x1 + (size_t)m * D) + lane;
            f32x4 v[4]; float s = 0.f;
#pragma unroll
            for (int j = 0; j < 4; ++j) { v[j] = xr[64 * j]; s += (v[j].x * v[j].x + v[j].y * v[j].y) + (v[j].z * v[j].z + v[j].w * v[j].w); }
            const float rs = 1.0f / sqrtf(wave_sum(s) * (1.f / D) + RMS_EPS);
            uint2* o8 = (uint2*)(hb + (size_t)m * D) + lane;
#pragma unroll
            for (int j = 0; j < 4; ++j) { uint2 o; o.x = pk2(v[j].x * rs * gn[j].x, v[j].y * rs * gn[j].y); o.y = pk2(v[j].z * rs * gn[j].z, v[j].w * rs * gn[j].w); o8[64 * j] = o; }
            float lg[36];
#pragma unroll
            for (int o = 0; o < 36; ++o) { float acc = 0.f;
#pragma unroll
                for (int j = 0; j < 4; ++j) { const f32x4 w = *(const LAS f32x4*)(Wr + o * 1024 + 256 * j + 4 * lane); acc += (v[j].x * w.x + v[j].y * w.y) + (v[j].z * w.z + v[j].w * w.w); }
                lg[o] = wave_sum(acc) * rs; }
            int gs = 0; float gmax = lg[0];
#pragma unroll
            for (int g = 1; g < 4; ++g) if (lg[g] > gmax) { gmax = lg[g]; gs = g; }
            float gden = 0.f;
#pragma unroll
            for (int g = 0; g < 4; ++g) gden += __expf(lg[g] - gmax);
            const float pgrp = 1.f / gden;
            float il[8];
#pragma unroll
            for (int e = 0; e < 8; ++e) { float vsel = lg[4 + e];
#pragma unroll
                for (int g = 1; g < 4; ++g) vsel = (gs == g) ? lg[4 + 8 * g + e] : vsel;
                il[e] = vsel; }
            int i0 = 0; float m0 = il[0];
#pragma unroll
            for (int e = 1; e < 8; ++e) if (il[e] > m0) { m0 = il[e]; i0 = e; }
            int i1 = -1; float m1 = -INFINITY;
#pragma unroll
            for (int e = 0; e < 8; ++e) if (e != i0 && il[e] > m1) { m1 = il[e]; i1 = e; }
            const float e1 = __expf(m1 - m0), w0 = pgrp / (1.f + e1), w1 = pgrp * e1 / (1.f + e1);
            if (lane == 0) {
                const int ex0 = gs * 8 + i0, ex1 = gs * 8 + i1;
                l_e[lr * 2] = ex0; l_e[lr * 2 + 1] = ex1; l_w[lr * 2] = w0; l_w[lr * 2 + 1] = w1;
                l_rank[lr * 2] = (int)atomicAdd((unsigned*)&lcnt[ex0], 1u); l_rank[lr * 2 + 1] = (int)atomicAdd((unsigned*)&lcnt[ex1], 1u);
            }
        }
        __syncthreads();
        if (tid < 32) gbase[tid] = __hip_atomic_fetch_add(gcnt + tid, lcnt[tid], __ATOMIC_RELAXED, __HIP_MEMORY_SCOPE_AGENT);
        __syncthreads();
        if (tid < 256) { const int m2 = chunk * 256 + tid; const int e = l_e[tid];
            tok_e[m2] = e; tok_w[m2] = l_w[tid]; tok_r[m2] = (int)gbase[e] + l_rank[tid]; }
        __syncthreads();
    }
}

__device__ __forceinline__ void p6_gather(const Args& a, const Ctx& F) {
    LANE_TID;
    unsigned char* ws = a.ws;
    const bf16* hb = (const bf16*)(ws + WS_HB); bf16* xs = (bf16*)(ws + WS_XS);
    const int* tok_e = (const int*)(ws + WS_TOKE); const float* tok_w = (const float*)(ws + WS_TOKW); const int* tok_r = (const int*)(ws + WS_TOKR);
    int* rowmap = (int*)(ws + WS_ROWMAP); float* roww = (float*)(ws + WS_ROWW); int* tile_e = (int*)(ws + WS_TILEE);
    const unsigned* gcnt = (const unsigned*)(ws + WS_CTL) + CW_CNT; unsigned* ntw = (unsigned*)(ws + WS_CTL) + CW_NT;
    LAS int* off = (LAS int*)(F.lds);
    LAS int* cntl = off + 64;
    if (tid == 0) { int o = 0;
        for (int e = 0; e < NE; ++e) { const int c = (int)__hip_atomic_load(gcnt + e, __ATOMIC_RELAXED, __HIP_MEMORY_SCOPE_AGENT); off[e] = o; cntl[e] = c; o += ((c + 255) >> 8) << 8; }
        off[NE] = o; }
    __syncthreads();
    if (F.bid == 0) {
        const int nt = off[NE] >> 8;
        if (tid == 0) __hip_atomic_store(ntw, (unsigned)nt, __ATOMIC_RELAXED, __HIP_MEMORY_SCOPE_AGENT);
        for (int mt = tid; mt < nt; mt += NTHREADS) { int e = 0;
            for (int k = 1; k < NE; ++k) if (off[k] <= mt * 256) e = k;
            tile_e[mt] = e; }
        for (int e = 0; e < NE; ++e) for (int r = off[e] + cntl[e] + tid; r < off[e + 1]; r += NTHREADS) { rowmap[r] = 2 * T; roww[r] = 0.f; }
    }
    const int gw = F.bid * NWAVES + F.wave, NGW = F.G * NWAVES;
    for (int p = gw; p < 2 * T; p += NGW) {
        const int e = tok_e[p], r = off[e] + tok_r[p], t = p >> 1;
        const v4u* src = (const v4u*)(hb + (size_t)t * D); v4u* dst = (v4u*)(xs + (size_t)r * D);
        const v4u w0 = src[lane], w1 = src[64 + lane];
        dst[lane] = w0; dst[64 + lane] = w1;
        if (lane == 0) { rowmap[r] = p; roww[r] = tok_w[p]; }
    }
}

__device__ __forceinline__ void p9_final(const Args& a, const Ctx& F) {
    LANE_TID;
    const bf16* y2 = (const bf16*)(a.ws + WS_Y2);
    const int gw = F.bid * NWAVES + F.wave, NGW = F.G * NWAVES;
    f32x4 gn[4];
#pragma unroll
    for (int j = 0; j < 4; ++j) gn[j] = ((const f32x4*)a.final_norm)[64 * j + lane];
    for (int m = gw; m < T; m += NGW) {
        f32x4* xr = (f32x4*)(a.out + (size_t)m * D) + lane;
        const uint2* ya = (const uint2*)(y2 + (size_t)(2 * m) * D) + lane; const uint2* yb = (const uint2*)(y2 + (size_t)(2 * m + 1) * D) + lane;
        f32x4 v[4]; float s = 0.f;
#pragma unroll
        for (int j = 0; j < 4; ++j) { v[j] = xr[64 * j]; const uint2 p = ya[64 * j], q = yb[64 * j];
            v[j].x += bflo(p.x) + bflo(q.x); v[j].y += bfhi(p.x) + bfhi(q.x); v[j].z += bflo(p.y) + bflo(q.y); v[j].w += bfhi(p.y) + bfhi(q.y);
            s += (v[j].x * v[j].x + v[j].y * v[j].y) + (v[j].z * v[j].z + v[j].w * v[j].w); }
        const float rs = 1.0f / sqrtf(wave_sum(s) * (1.f / D) + RMS_EPS);
#pragma unroll
        for (int j = 0; j < 4; ++j) { f32x4 o; o.x = v[j].x * rs * gn[j].x; o.y = v[j].y * rs * gn[j].y; o.z = v[j].z * rs * gn[j].z; o.w = v[j].w * rs * gn[j].w; xr[64 * j] = o; }
    }
}

#ifndef MK_ONE_LAUNCH
#define MK_ONE_LAUNCH 0
#endif
constexpr int N_PHASES = 10;
__global__ void __launch_bounds__(NTHREADS, 2) mega_fwd(Args a) {
    extern __shared__ __attribute__((aligned(16))) unsigned char lds_raw[];
    Ctx F; F.lds = (LAS unsigned char*)lds_raw; F.wave = __builtin_amdgcn_readfirstlane((int)(threadIdx.x >> 6)); F.G = gridDim.x; F.bid = blockIdx.x;
    const int lo = a.ph_lo, hi = a.ph_hi;
    unsigned char* ws = a.ws;
#ifndef PH_MASK
#define PH_MASK 0x3ff
#endif
#define IN(k) (((PH_MASK >> (k)) & 1) && lo <= (k) && (k) < hi)
#if MK_ONE_LAUNCH
#define SEAM(k) do { if (IN(k) && IN((k) + 1)) cg::this_grid().sync(); } while (0)
#else
#define SEAM(k) do { } while (0)
#endif
    if (IN(0)) p0_prologue(a, F);
    SEAM(0);
    if (IN(1)) {
        pg8::Gemm g{(const pg8::bf16_t*)(ws + WS_HB), (const pg8::bf16_t*)(ws + WS_WIN), D, D};
        pg8::StaticOrder S; S.init(T, NP, F.G, F.bid);
        pg8::EpiStoreBf16 E{(pg8::bf16_t*)(ws + WS_P), NP, 0, 1.f};
        pg8::gemm_phase<pg8::EpiStoreBf16, pg8::StaticOrder, true, true>(F.lds, g, S, E, F.wave);
    }
    SEAM(1);
    if (IN(2)) p2_kmean(a, F);
    SEAM(2);
    if (IN(3)) { p3_gdn_naive(a, F); p3_attn_naive(a, F); }
    SEAM(3);
    if (IN(4)) {
        pg8::Gemm g{(const pg8::bf16_t*)(ws + WS_P), (const pg8::bf16_t*)(ws + WS_WOUT), NP, D};
        pg8::StaticOrder S; S.init(T, D, F.G, F.bid);
        pg8::EpiResF32 E{a.x, a.out, D};
        pg8::gemm_phase<pg8::EpiResF32, pg8::StaticOrder, true, true>(F.lds, g, S, E, F.wave);
    }
    SEAM(4);
    if (IN(5)) p5_router(a, F);
    SEAM(5);
    if (IN(6)) p6_gather(a, F);
    SEAM(6);
    if (IN(7)) {
        const int nt = (int)__hip_atomic_load((const unsigned*)(ws + WS_CTL) + CW_NT, __ATOMIC_RELAXED, __HIP_MEMORY_SCOPE_AGENT);
        pg8::Gemm g{(const pg8::bf16_t*)(ws + WS_XS), (const pg8::bf16_t*)(ws + WS_WGU), D, D};
        pg8::MoeOrder S{(const int*)(ws + WS_TILEE), nt, 2, F.G, F.bid};
        pg8::EpiGateUp E{(pg8::bf16_t*)(ws + WS_HID), (const float*)(ws + WS_ROWW)};
        pg8::gemm_phase<pg8::EpiGateUp, pg8::MoeOrder, true, true>(F.lds, g, S, E, F.wave);
    }
    SEAM(7);
    if (IN(8)) {
        const int nt = (int)__hip_atomic_load((const unsigned*)(ws + WS_CTL) + CW_NT, __ATOMIC_RELAXED, __HIP_MEMORY_SCOPE_AGENT);
        pg8::Gemm g{(const pg8::bf16_t*)(ws + WS_HID), (const pg8::bf16_t*)(ws + WS_WD), FF, FF};
        pg8::MoeOrder S{(const int*)(ws + WS_TILEE), nt, 4, F.G, F.bid};
        pg8::EpiDown E{(pg8::bf16_t*)(ws + WS_Y2), (const int*)(ws + WS_ROWMAP)};
        pg8::gemm_phase<pg8::EpiDown, pg8::MoeOrder, true, true>(F.lds, g, S, E, F.wave);
    }
    SEAM(8);
    if (IN(9)) p9_final(a, F);
#undef IN
#undef SEAM
}

extern "C" void kernel_launch(void* const* d_in, const int* in_sizes, int n_in, void* d_out, int out_size, void* d_ws, size_t ws_size, hipStream_t stream) {
    static int grid = 0;
    if (grid == 0) {
        int dev = 0, cus = 0, per_cu = 0;
        hipGetDevice(&dev); hipDeviceGetAttribute(&cus, hipDeviceAttributeMultiprocessorCount, dev);
        hipFuncSetAttribute((const void*)mega_fwd, hipFuncAttributeMaxDynamicSharedMemorySize, LDS_BYTES);
        hipOccupancyMaxActiveBlocksPerMultiprocessor(&per_cu, (const void*)mega_fwd, NTHREADS, LDS_BYTES);
        if (per_cu < 1) { fprintf(stderr, "kernel_launch: occupancy query says %d blocks/CU\n", per_cu); per_cu = 1; }
        grid = cus * 1;
        if (ws_size < WS_END) { fprintf(stderr, "kernel_launch: workspace too small (%zu < %zu)\n", ws_size, (size_t)WS_END); grid = -1; }
    }
    if (grid < 0) return;
    hipMemsetAsync((char*)d_ws + WS_CTL, 0, CTL_ZERO_BYTES, stream);
    Args a{};
    a.x = (const float*)d_in[0]; a.attn_norm = (const float*)d_in[1]; a.w_in = (const float*)d_in[2]; a.conv_w = (const float*)d_in[3]; a.A_log = (const float*)d_in[4];
    a.dt_bias = (const float*)d_in[5]; a.gdn_norm = (const float*)d_in[6]; a.w_out = (const float*)d_in[7]; a.ffn_norm = (const float*)d_in[8]; a.w_group = (const float*)d_in[9];
    a.w_router = (const float*)d_in[10]; a.w_gate = (const float*)d_in[11]; a.w_up = (const float*)d_in[12]; a.w_down = (const float*)d_in[13]; a.final_norm = (const float*)d_in[14];
    a.out = (float*)d_out; a.ws = (unsigned char*)d_ws;
#if MK_ONE_LAUNCH
    a.ph_lo = 0; a.ph_hi = N_PHASES;
    void* args[] = {&a};
    hipError_t e = hipLaunchCooperativeKernel((const void*)mega_fwd, dim3(grid), dim3(NTHREADS), args, LDS_BYTES, stream);
    if (e != hipSuccess) fprintf(stderr, "cooperative launch failed: %s (grid %d)\n", hipGetErrorString(e), grid);
#else
    for (int p = 0; p < N_PHASES; ++p) { a.ph_lo = p; a.ph_hi = p + 1; hipLaunchKernelGGL(mega_fwd, dim3(grid), dim3(NTHREADS), LDS_BYTES, stream, a); }
#endif
}
```

```cpp
#include <hip/hip_runtime.h>
#include <hip/hip_cooperative_groups.h>
#include <cstdio>
#include <cstdint>
namespace cg = cooperative_groups;
namespace pg8 {
#define PG8_LAS __attribute__((address_space(3)))
typedef unsigned short bf16_t;
typedef short bf16x8 __attribute__((ext_vector_type(8)));
typedef float f32x4 __attribute__((ext_vector_type(4)));
typedef unsigned u32x4 __attribute__((ext_vector_type(4)));
constexpr int BM = 256, BK = 64, HALF = 128, HTB = HALF * BK * 2  , STAGE_BYTES = 8 * HTB, NXCD = 8, WGM = 8;

__host__ __device__ __forceinline__ int lds_byte(int r, int c) { const int st = (r >> 4) * 2 + (c >> 5), rr = r & 15, cc = c & 31, ob = rr * 64 + cc * 2; return st * 1024 + (ob ^ (((ob >> 9) & 1) << 5)); }
__host__ __device__ __forceinline__ void stage_rc(int b, int& R, int& C) { const int st = b / 1024, sb = b % 1024, swz = sb ^ (((sb >> 9) & 1) << 5); R = (st >> 1) * 16 + swz / 64; C = (st & 1) * 32 + (swz % 64) / 2; }
__host__ __device__ __forceinline__ int perm32(int rho) { const int n = rho >> 4, i = rho & 15; return 8 * (i >> 2) + 4 * n + (i & 3); }

struct Unit { int pm, pn; };
struct Gemm { const bf16_t* A; const bf16_t* Bt; int lda, K; };

struct StaticOrder {
    int nM, nN, nwg, G, c;
    __host__ __device__ void init(int M, int N, int G_, int c_) { nM = M / BM; nN = N / BM; nwg = nM * nN; G = G_; c = c_; }
    __host__ __device__ bool next(int i, Unit& u) const {
        const long L = (long)i * G + c; if (L >= nwg) return false;
        int wgid = (int)L; { const int q = nwg / NXCD, r = nwg % NXCD, xcd = wgid % NXCD, off = wgid / NXCD; wgid = (xcd < r ? xcd * (q + 1) : r * (q + 1) + (xcd - r) * q) + off; }
        const int nig = WGM * nN, gid = wgid / nig, fm = gid * WGM, gsz = (nM - fm) < WGM ? (nM - fm) : WGM;
        u.pm = fm + ((wgid % nig) % gsz); u.pn = (wgid % nig) / gsz; return true;
    }
    __device__ __forceinline__ void a_ready(const Unit&) const {}
    __device__ __forceinline__ void done(const Unit&) const {}
};

__device__ __forceinline__ unsigned cvt_pk_bf16(float lo, float hi) { unsigned r; asm volatile("v_cvt_pk_bf16_f32 %0, %1, %2" : "=v"(r) : "v"(lo), "v"(hi)); return r; }

struct EpiStoreBf16 {
    static constexpr bool PERM = true, AFTER_DRAIN = false;
    bf16_t* O; int ldc; int scale_cols; float scale0;
    __device__ __forceinline__ void operator()(const f32x4 (&acc)[2][2][4][2], const Unit& u, int wr, int wc, int fr, int fq) const {
        const int row0 = u.pm * BM + wr * 64 + fr; const int colt = u.pn * BM;
        const float sc = (colt < scale_cols) ? scale0 : 1.f;
        const int col0 = colt + wc * 32 + 8 * fq;
#pragma unroll
        for (int ai = 0; ai < 2; ++ai)
#pragma unroll
            for (int m = 0; m < 4; ++m) { bf16_t* rowp = O + (size_t)(row0 + ai * HALF + m * 16) * ldc + col0;
#pragma unroll
                for (int bj = 0; bj < 2; ++bj) { const f32x4 v0 = acc[ai][bj][m][0] * sc, v1 = acc[ai][bj][m][1] * sc;
                    u32x4 w; w.x = cvt_pk_bf16(v0[0], v0[1]); w.y = cvt_pk_bf16(v0[2], v0[3]); w.z = cvt_pk_bf16(v1[0], v1[1]); w.w = cvt_pk_bf16(v1[2], v1[3]);
                    *(u32x4*)(rowp + bj * HALF) = w; } }
    }
};
struct EpiResF32 {
    static constexpr bool PERM = false, AFTER_DRAIN = false;
    const float* base; float* out; int ldc;
    __device__ __forceinline__ void operator()(const f32x4 (&acc)[2][2][4][2], const Unit& u, int wr, int wc, int fr, int fq) const {
        const int row0 = u.pm * BM + wr * 64 + fr, col0 = u.pn * BM + wc * 32 + 4 * fq;
#pragma unroll
        for (int ai = 0; ai < 2; ++ai)
#pragma unroll
            for (int m = 0; m < 4; ++m) { const size_t off = (size_t)(row0 + ai * HALF + m * 16) * ldc + col0;
#pragma unroll
                for (int bj = 0; bj < 2; ++bj)
#pragma unroll
                    for (int n = 0; n < 2; ++n) { const f32x4 b = *(const f32x4*)(base + off + bj * HALF + n * 16); *(f32x4*)(out + off + bj * HALF + n * 16) = b + acc[ai][bj][m][n]; } }
    }
};
struct EpiGateUp {
    static constexpr bool PERM = true, AFTER_DRAIN = false;
    bf16_t* hid; const float* roww;
    __device__ __forceinline__ void operator()(const f32x4 (&acc)[2][2][4][2], const Unit& u, int wr, int wc, int fr, int fq) const {
        const int row0 = u.pm * BM + wr * 64 + fr; const int hc0 = (u.pn & 1) * 128 + 16 * wc + 4 * fq;
#pragma unroll
        for (int ai = 0; ai < 2; ++ai)
#pragma unroll
            for (int m = 0; m < 4; ++m) { const int r = row0 + ai * HALF + m * 16; const float w = roww[r]; bf16_t* rowp = hid + (size_t)r * 256 + hc0;
#pragma unroll
                for (int bj = 0; bj < 2; ++bj) { const f32x4 v0 = acc[ai][bj][m][0], v1 = acc[ai][bj][m][1];
                    const float h0 = v0[0] / (1.f + __expf(-v0[0])) * v0[1] * w, h1 = v0[2] / (1.f + __expf(-v0[2])) * v0[3] * w;
                    const float h2 = v1[0] / (1.f + __expf(-v1[0])) * v1[1] * w, h3 = v1[2] / (1.f + __expf(-v1[2])) * v1[3] * w;
                    uint2 o; o.x = cvt_pk_bf16(h0, h1); o.y = cvt_pk_bf16(h2, h3);
                    *(uint2*)(rowp + bj * 64) = o; } }
    }
};
struct EpiDown {
    static constexpr bool PERM = true, AFTER_DRAIN = false;
    bf16_t* y2; const int* rowmap;
    __device__ __forceinline__ void operator()(const f32x4 (&acc)[2][2][4][2], const Unit& u, int wr, int wc, int fr, int fq) const {
        const int row0 = u.pm * BM + wr * 64 + fr; const int col0 = (u.pn & 3) * 256 + wc * 32 + 8 * fq;
#pragma unroll
        for (int ai = 0; ai < 2; ++ai)
#pragma unroll
            for (int m = 0; m < 4; ++m) { int r = row0 + ai * HALF + m * 16; asm volatile("" : "+v"(r)); const int dst = rowmap[r];
                bf16_t* rowp = y2 + (size_t)dst * 1024 + col0;
#pragma unroll
                for (int bj = 0; bj < 2; ++bj) { const f32x4 v0 = acc[ai][bj][m][0], v1 = acc[ai][bj][m][1];
                    u32x4 w; w.x = cvt_pk_bf16(v0[0], v0[1]); w.y = cvt_pk_bf16(v0[2], v0[3]); w.z = cvt_pk_bf16(v1[0], v1[1]); w.w = cvt_pk_bf16(v1[2], v1[3]);
                    *(u32x4*)(rowp + bj * HALF) = w; } }
    }
};
struct MoeOrder {
    const int* tile_e; int ntiles, nsub, G, c;
    __device__ __forceinline__ bool next(int i, Unit& u) const {
        const int L = i * G + c; if (L >= ntiles * nsub) return false;
        const int mt = L / nsub, j = L - mt * nsub; u.pm = mt; u.pn = tile_e[mt] * nsub + j; return true;
    }
    __device__ __forceinline__ void a_ready(const Unit&) const {}
    __device__ __forceinline__ void done(const Unit&) const {}
};

template <class Epi, class Sched, bool ALIGN_EPI = false, bool SP2 = false>
__device__ __forceinline__ void gemm_phase(PG8_LAS unsigned char* lds, const Gemm g, const Sched& S, const Epi& E, const int wid) {
    const int lane = (int)__builtin_amdgcn_mbcnt_hi(~0u, __builtin_amdgcn_mbcnt_lo(~0u, 0u)), tid = wid * 64 + lane, wr = wid >> 2, wc = wid & 3, fr = lane & 15, fq = lane >> 4;
    const int K = g.K, nt = K / BK, lda = g.lda;
    unsigned voffA[2], voffB[2];
#pragma unroll
    for (int i = 0; i < 2; ++i) { int R, C; stage_rc(tid * 16 + i * 8192, R, C); const int Rb = Epi::PERM ? ((R & ~31) + perm32(R & 31)) : R;
        voffA[i] = (unsigned)(R * lda + C) * 2u; voffB[i] = (unsigned)(Rb * K + C) * 2u; }
    const size_t kstep = (size_t)(BK * 2);
    const size_t hstepA = (size_t)HALF * lda * 2, hstepB = (size_t)HALF * K * 2;
    const size_t tstepA = 2 * hstepA, tstepB = 2 * hstepB;
    const unsigned ldsw = (unsigned)wid * 1024u;
    const int aoff = lds_byte(wr * 64 + fr, fq * 8), boff = lds_byte(wc * 32 + fr, fq * 8);
#define PG8_SA(b, h) (((b) * 2 + (h)) * HTB)
#define PG8_SB(b, h) ((4 + (b) * 2 + (h)) * HTB)
#define PG8_STAGE(bufoff, gbase, voff) do { _Pragma("unroll") for (int _i = 0; _i < 2; ++_i) \
        __builtin_amdgcn_global_load_lds((const unsigned*)((const char*)(gbase) + (voff)[_i]), (PG8_LAS unsigned*)(lds + (bufoff) + ldsw + _i * 8192), 16, 0, 0); } while (0)
#define PG8_LDA(dst, b, h) do { _Pragma("unroll") for (int m = 0; m < 4; ++m) _Pragma("unroll") for (int k = 0; k < 2; ++k) dst[m][k] = *(const PG8_LAS bf16x8*)(lds + PG8_SA(b, h) + aoff + m * 2048 + k * 1024); } while (0)
#define PG8_LDB(dst, b, h) do { _Pragma("unroll") for (int n = 0; n < 2; ++n) _Pragma("unroll") for (int k = 0; k < 2; ++k) dst[n][k] = *(const PG8_LAS bf16x8*)(lds + PG8_SB(b, h) + boff + n * 2048 + k * 1024); } while (0)
#define PG8_MMA(ai, bj, At, Bt) do { __builtin_amdgcn_s_setprio(1); _Pragma("unroll") for (int m = 0; m < 4; ++m) _Pragma("unroll") for (int n = 0; n < 2; ++n) _Pragma("unroll") for (int k = 0; k < 2; ++k) \
        acc[ai][bj][m][n] = __builtin_amdgcn_mfma_f32_16x16x32_bf16(Bt[n][k], At[m][k], acc[ai][bj][m][n], 0, 0, 0); __builtin_amdgcn_s_setprio(0); } while (0)
#define PG8_WAIT_V(n) asm volatile("s_waitcnt vmcnt(" #n ")" ::: "memory")
#define PG8_WAIT_L(n) asm volatile("s_waitcnt lgkmcnt(" #n ")" ::: "memory")
#define PG8_BAR __builtin_amdgcn_s_barrier()
#define PG8_SCHED __builtin_amdgcn_sched_barrier(0)
    Unit cur, nxt; int ui = 0;
    if (!S.next(0, cur)) return;
    f32x4 acc[2][2][4][2];
#pragma unroll
    for (int a = 0; a < 2; ++a)
#pragma unroll
        for (int b = 0; b < 2; ++b)
#pragma unroll
            for (int m = 0; m < 4; ++m)
#pragma unroll
                for (int n = 0; n < 2; ++n) acc[a][b][m][n] = (f32x4){0.f, 0.f, 0.f, 0.f};
    bf16x8 At[4][2], B0[2][2], B1[2][2];
    const char* cA = (const char*)g.A + (size_t)cur.pm * tstepA; const char* cB = (const char*)g.Bt + (size_t)cur.pn * tstepB;
    S.a_ready(cur);
    if constexpr (SP2) {
        PG8_STAGE(PG8_SB(0, 0), cB, voffB); PG8_STAGE(PG8_SB(0, 1), cB + hstepB, voffB); PG8_STAGE(PG8_SA(0, 0), cA, voffA); PG8_STAGE(PG8_SA(0, 1), cA + hstepA, voffA);
        if (wr == 1) PG8_BAR;
        PG8_WAIT_V(2); PG8_BAR;
        PG8_STAGE(PG8_SB(1, 0), cB + kstep, voffB); PG8_STAGE(PG8_SA(1, 0), cA + kstep, voffA); PG8_STAGE(PG8_SB(1, 1), cB + hstepB + kstep, voffB);
        PG8_WAIT_V(6); PG8_BAR;
    } else {
        PG8_STAGE(PG8_SB(0, 0), cB, voffB); PG8_STAGE(PG8_SA(0, 0), cA, voffA); PG8_STAGE(PG8_SB(0, 1), cB + hstepB, voffB); PG8_STAGE(PG8_SA(0, 1), cA + hstepA, voffA);
        if (wr == 1) PG8_BAR;
        PG8_WAIT_V(4); PG8_BAR;
        PG8_STAGE(PG8_SB(1, 0), cB + kstep, voffB); PG8_STAGE(PG8_SA(1, 0), cA + kstep, voffA); PG8_STAGE(PG8_SB(1, 1), cB + hstepB + kstep, voffB);
        PG8_WAIT_V(6); PG8_BAR;
    }
    for (;;) {
        const bool has_next = S.next(ui + 1, nxt);
        const char* nA = has_next ? (const char*)g.A + (size_t)nxt.pm * tstepA : cA; const char* nB = has_next ? (const char*)g.Bt + (size_t)nxt.pn * tstepB : cB;
        for (int t = 0; t < nt; t += 2) {
            const bool last = (t == nt - 2);
            const char* a1 = cA + (size_t)(t + 1) * kstep;
            const char* a2 = last ? nA : cA + (size_t)(t + 2) * kstep; const char* b2 = last ? nB : cB + (size_t)(t + 2) * kstep;
            const char* a3 = a2 + kstep; const char* b3 = b2 + kstep;
            if (last && has_next) S.a_ready(nxt);
            if constexpr (SP2) {
            PG8_LDB(B0, 0, 0); PG8_LDB(B1, 0, 1); PG8_SCHED; PG8_LDA(At, 0, 0); PG8_STAGE(PG8_SA(1, 1), a1 + hstepA, voffA);
            PG8_WAIT_V(8); PG8_WAIT_L(0); PG8_BAR; PG8_MMA(0, 0, At, B0); PG8_MMA(0, 1, At, B1); PG8_BAR; PG8_SCHED;
            PG8_LDA(At, 0, 1); PG8_STAGE(PG8_SB(0, 0), b2, voffB); PG8_STAGE(PG8_SB(0, 1), b2 + hstepB, voffB); PG8_STAGE(PG8_SA(0, 0), a2, voffA);
            PG8_WAIT_V(8); PG8_WAIT_L(0); PG8_BAR; PG8_MMA(1, 0, At, B0); PG8_MMA(1, 1, At, B1); PG8_BAR; PG8_SCHED;
            PG8_LDB(B0, 1, 0); PG8_LDB(B1, 1, 1); PG8_SCHED; PG8_LDA(At, 1, 0); PG8_STAGE(PG8_SA(0, 1), a2 + hstepA, voffA);
            PG8_WAIT_V(8); PG8_WAIT_L(0); PG8_BAR; PG8_MMA(0, 0, At, B0); PG8_MMA(0, 1, At, B1); PG8_BAR; PG8_SCHED;
            PG8_LDA(At, 1, 1); PG8_STAGE(PG8_SB(1, 0), b3, voffB); PG8_STAGE(PG8_SB(1, 1), b3 + hstepB, voffB); PG8_STAGE(PG8_SA(1, 0), a3, voffA);
            PG8_WAIT_V(8); PG8_WAIT_L(0); PG8_BAR; PG8_MMA(1, 0, At, B0); PG8_MMA(1, 1, At, B1); PG8_BAR; PG8_SCHED;
            } else {
            PG8_LDB(B0, 0, 0); PG8_SCHED; PG8_LDA(At, 0, 0); PG8_STAGE(PG8_SA(1, 1), a1 + hstepA, voffA);
            PG8_WAIT_L(8); PG8_BAR; PG8_WAIT_L(0); PG8_MMA(0, 0, At, B0); PG8_BAR; PG8_SCHED;
            PG8_LDB(B1, 0, 1); PG8_STAGE(PG8_SB(0, 0), b2, voffB);
            PG8_BAR; PG8_WAIT_L(0); PG8_MMA(0, 1, At, B1); PG8_BAR;
            PG8_LDA(At, 0, 1); PG8_STAGE(PG8_SA(0, 0), a2, voffA);
            PG8_BAR; PG8_WAIT_L(0); PG8_MMA(1, 0, At, B0); PG8_BAR; PG8_SCHED;
            PG8_STAGE(PG8_SB(0, 1), b2 + hstepB, voffB);
            PG8_WAIT_V(6); PG8_BAR; PG8_MMA(1, 1, At, B1); PG8_BAR;
            PG8_LDB(B0, 1, 0); PG8_SCHED; PG8_LDA(At, 1, 0); PG8_STAGE(PG8_SA(0, 1), a2 + hstepA, voffA);
            PG8_WAIT_L(8); PG8_BAR; PG8_WAIT_L(0); PG8_MMA(0, 0, At, B0); PG8_BAR; PG8_SCHED;
            PG8_LDB(B1, 1, 1); PG8_STAGE(PG8_SB(1, 0), b3, voffB);
            PG8_BAR; PG8_WAIT_L(0); PG8_MMA(0, 1, At, B1); PG8_BAR;
            PG8_LDA(At, 1, 1); PG8_STAGE(PG8_SA(1, 0), a3, voffA);
            PG8_BAR; PG8_WAIT_L(0); PG8_MMA(1, 0, At, B0); PG8_BAR; PG8_SCHED;
            PG8_STAGE(PG8_SB(1, 1), b3 + hstepB, voffB);
            PG8_WAIT_V(6); PG8_BAR; PG8_MMA(1, 1, At, B1); PG8_BAR;
            }
        }
        if constexpr (ALIGN_EPI) { if (wr == 0) PG8_BAR; }
        if constexpr (!Epi::AFTER_DRAIN) { E(acc, cur, wr, wc, fr, fq); S.done(cur); }
        if (!has_next) break;
#pragma unroll
        for (int a = 0; a < 2; ++a)
#pragma unroll
            for (int b = 0; b < 2; ++b)
#pragma unroll
                for (int m = 0; m < 4; ++m)
#pragma unroll
                    for (int n = 0; n < 2; ++n) acc[a][b][m][n] = (f32x4){0.f, 0.f, 0.f, 0.f};
        cur = nxt; cA = nA; cB = nB; ++ui;
        if constexpr (ALIGN_EPI) { if (wr == 1) PG8_BAR; }
    }
    PG8_WAIT_V(0);
    if constexpr (!ALIGN_EPI) { if (wr == 0) PG8_BAR; }
    PG8_BAR;
    if constexpr (Epi::AFTER_DRAIN) { E.fused(acc, cur, wr, wc, fr, fq, lds, wid, lane); S.done(cur); }
#undef PG8_SA
#undef PG8_SB
#undef PG8_STAGE
#undef PG8_LDA
#undef PG8_LDB
#undef PG8_MMA
#undef PG8_WAIT_V
#undef PG8_WAIT_L
#undef PG8_BAR
#undef PG8_SCHED
}
}

#define GAS __attribute__((address_space(1)))
#define LAS __attribute__((address_space(3)))
typedef unsigned short bf16;
typedef unsigned v4u __attribute__((ext_vector_type(4)));
typedef float f32x4 __attribute__((ext_vector_type(4)));

constexpr int NWAVES = 8, NTHREADS = NWAVES * 64;
constexpr int NB = 16, NS = 2048, T = NB * NS, D = 1024;
constexpr int NP = 3584;
constexpr int PC_MQ = 0, PC_GZ = 512, PC_MK = 1024, PC_MV = 1536, PC_GQ = 2048, PC_GK = 2560, PC_GV = 3072;
constexpr int WIN_LD = 3592;
constexpr int MH = 8, MD = 64, MBLK = 256, MNB = NS / MBLK;
constexpr int GH = 4, GD = 128;
constexpr int NE = 32, FF = 256;
constexpr int MAXTILES = 288, MAXROWS = MAXTILES * 256;
constexpr float RMS_EPS = 1e-6f;

constexpr size_t MiB = 1u << 20;
constexpr size_t WS_CTL = 0, CTL_ZERO_BYTES = 1 * MiB;
constexpr size_t WS_WIN = 1 * MiB, WS_WOUT = 8 * MiB, WS_WGU = 10 * MiB, WS_WD = 42 * MiB;
constexpr size_t WS_GAB = 58 * MiB, WS_KMEAN = 59 * MiB;
constexpr size_t WS_TOKE = 60 * MiB, WS_TOKW = WS_TOKE + 256 * 1024, WS_TOKR = WS_TOKW + 256 * 1024, WS_ROWMAP = WS_TOKR + 256 * 1024, WS_ROWW = WS_ROWMAP + 512 * 1024, WS_TILEE = WS_ROWW + 512 * 1024;
constexpr size_t WS_HB = 64 * MiB;
constexpr size_t WS_P = 128 * MiB;
constexpr size_t WS_XS = WS_P;
constexpr size_t WS_HID = WS_P + 144 * MiB;
constexpr size_t WS_Y2 = 352 * MiB;
constexpr size_t WS_END = 481 * MiB;
static_assert(WS_TILEE + 4096 <= WS_HB && WS_HID + (size_t)MAXROWS * 256 * 2 <= WS_Y2 && WS_P + (size_t)T * NP * 2 <= WS_Y2, "ws map");
constexpr int CW_CNT = 64;
constexpr int CW_NT = 128;
constexpr int CW_BAR = 4096;

constexpr int LDS_BYTES = 155648;
constexpr int LDS_CTL_OFF = LDS_BYTES - 256;

__device__ __forceinline__ unsigned f2bf(float f) { unsigned u = __builtin_bit_cast(unsigned, f); return (u + 0x7fffu + ((u >> 16) & 1u)) >> 16; }
__device__ __forceinline__ unsigned pk2(float lo, float hi) { return f2bf(lo) | (f2bf(hi) << 16); }
__device__ __forceinline__ float bflo(unsigned u) { return __builtin_bit_cast(float, u << 16); }
__device__ __forceinline__ float bfhi(unsigned u) { return __builtin_bit_cast(float, u & 0xffff0000u); }
__device__ __forceinline__ float bf2f(bf16 h) { return __builtin_bit_cast(float, (unsigned)h << 16); }
__device__ __forceinline__ float wave_sum(float v) {
#pragma unroll
    for (int o = 1; o < 64; o <<= 1) v += __shfl_xor(v, o);
    return v;
}
__device__ __forceinline__ float siluf(float x) { return x / (1.f + __expf(-x)); }

struct Args {
    const float* x; const float* attn_norm; const float* w_in; const float* conv_w; const float* A_log; const float* dt_bias; const float* gdn_norm; const float* w_out;
    const float* ffn_norm; const float* w_group; const float* w_router; const float* w_gate; const float* w_up; const float* w_down; const float* final_norm;
    float* out; unsigned char* ws; int ph_lo, ph_hi;
};

struct Ctx {
    LAS unsigned char* lds; int wave, G, bid;
};
__device__ __forceinline__ int lane_id() { return (int)__builtin_amdgcn_mbcnt_hi(~0u, __builtin_amdgcn_mbcnt_lo(~0u, 0u)); }
#define LANE_TID const int lane = lane_id(), tid = F.wave * 64 + lane; (void)tid; (void)lane


#define XB_TMO      128
#define XB_XCNT(j)  (256  + 64 * (j))
#define XB_XSUB(j)  (1280 + 64 * (j))
#define XB_XGEN(j)  (2304 + 64 * (j))
#define XB_TOP      3328
#define XB_TOPGEN   3392
#define XCD_BAR_WORDS 3456
#define XB_SPIN_CAP (1u << 20)
__device__ __forceinline__ unsigned xb_ld(unsigned* p)              { return __hip_atomic_load(p, __ATOMIC_RELAXED, __HIP_MEMORY_SCOPE_AGENT); }
__device__ __forceinline__ unsigned xb_add(unsigned* p, unsigned v) { return __hip_atomic_fetch_add(p, v, __ATOMIC_RELAXED, __HIP_MEMORY_SCOPE_AGENT); }
__device__ __forceinline__ unsigned xb_xcc_id() { return (unsigned)__builtin_amdgcn_s_getreg((3 << 11) | 20) & 0xFu; }
#define XB_SPIN(cond, bar) do { unsigned _sp = 0; while (cond) { __builtin_amdgcn_s_sleep(1); \
    if ((++_sp & 255u) == 0u) { if (xb_ld(&(bar)[XB_TMO])) break; if (_sp > XB_SPIN_CAP) { atomicAdd(&(bar)[XB_TMO], 1u); break; } } } } while (0)
struct XcdBarrier { unsigned* bar; unsigned x; volatile LAS unsigned* st; };
__device__ __forceinline__ XcdBarrier xcd_barrier_post(unsigned* bar, volatile LAS unsigned* st, bool leader) {
    XcdBarrier b; b.bar = bar; b.x = xb_xcc_id(); b.st = st;
    if (leader) (void)xb_add(&bar[XB_XCNT(b.x)], 1u);
    return b;
}
__device__ __forceinline__ void xcd_barrier_complete(unsigned* bar, unsigned x, unsigned G, unsigned& nloc, unsigned& nx) {
    unsigned sum, cnt, mine, sp = 0u;
    for (;;) {
        sum = 0u; cnt = 0u; mine = 0u;
#pragma unroll
        for (unsigned j = 0; j < 16; ++j) { const unsigned c = xb_ld(&bar[XB_XCNT(j)]); sum += c; cnt += (c > 0u) ? 1u : 0u; mine = (j == x) ? c : mine; }
        if (sum == G) break;
        __builtin_amdgcn_s_sleep(1);
        if ((++sp & 255u) == 0u) { if (xb_ld(&bar[XB_TMO])) break; if (sp > XB_SPIN_CAP) { atomicAdd(&bar[XB_TMO], 1u); break; } }
    }
    nloc = mine > 0u ? mine : 1u; nx = cnt > 0u ? cnt : 1u;
}
__device__ __forceinline__ void xcd_barrier(const XcdBarrier& b, bool leader, unsigned G) {
    asm volatile("s_waitcnt vmcnt(0)" ::: "memory");
    __syncthreads();
    if (leader) {
        unsigned* bar = b.bar;
        __builtin_amdgcn_s_waitcnt(0);
        unsigned nloc = b.st[0], nx = b.st[1];
        if (nloc == 0u) { xcd_barrier_complete(bar, b.x, G, nloc, nx); b.st[0] = nloc; b.st[1] = nx; }
        const unsigned old = xb_add(&bar[XB_XSUB(b.x)], 1u);
        const unsigned gen = old / nloc;
        if (old + 1u == (gen + 1u) * nloc) {
            __builtin_amdgcn_fence(__ATOMIC_RELEASE, "agent");
            asm volatile("s_waitcnt vmcnt(0)" ::: "memory");
            const unsigned og = xb_add(&bar[XB_TOP], 1u);
            const unsigned tg = og / nx;
            if (og + 1u == (tg + 1u) * nx) xb_add(&bar[XB_TOPGEN], 1u);
            else XB_SPIN(xb_ld(&bar[XB_TOPGEN]) == tg, bar);
            __builtin_amdgcn_fence(__ATOMIC_ACQUIRE, "agent");
            xb_add(&bar[XB_XGEN(b.x)], 1u);
            asm volatile("s_waitcnt vmcnt(0)" ::: "memory");
        } else {
            XB_SPIN(xb_ld(&bar[XB_XGEN(b.x)]) == gen, bar);
            __builtin_amdgcn_fence(__ATOMIC_ACQUIRE, "agent");
            asm volatile("s_waitcnt vmcnt(0)" ::: "memory");
        }
    }
    __syncthreads();
}

__device__ __forceinline__ void tr_item(const float* W, int ldn, int ncol0, int K, int nblk, bf16* WT, int row_off, int rmul, LAS float* scr, int item, int lane) {
    const int kb = item / nblk, nb = item - kb * nblk, k0 = 64 * kb, n0 = 32 * nb;
#pragma unroll 8
    for (int i = 0; i < 32; ++i) { const int kk = 2 * i + (lane >> 5); scr[kk * 33 + (lane & 31)] = W[(size_t)(k0 + kk) * ldn + ncol0 + n0 + (lane & 31)]; }
    asm volatile("s_waitcnt lgkmcnt(0)" ::: "memory");
    const int c = lane & 7;
#pragma unroll
    for (int j = 0; j < 4; ++j) { const int n = (lane >> 3) + 8 * j; const LAS float* s = scr + (8 * c) * 33 + n;
        v4u o; o.x = pk2(s[0 * 33], s[1 * 33]); o.y = pk2(s[2 * 33], s[3 * 33]); o.z = pk2(s[4 * 33], s[5 * 33]); o.w = pk2(s[6 * 33], s[7 * 33]);
        *(v4u*)(WT + (size_t)(row_off + rmul * (n0 + n)) * K + k0 + 8 * c) = o; }
    asm volatile("s_waitcnt lgkmcnt(0)" ::: "memory");
}

__device__ __forceinline__ void p0_prologue(const Args& a, const Ctx& F) {
    LANE_TID;
    unsigned char* ws = a.ws;
    bf16* Win_t = (bf16*)(ws + WS_WIN); bf16* Wout_t = (bf16*)(ws + WS_WOUT); bf16* Wgu_t = (bf16*)(ws + WS_WGU); bf16* Wd_t = (bf16*)(ws + WS_WD);
    LAS float* scr = (LAS float*)(F.lds + F.wave * 8704);
    const int gw = F.bid * NWAVES + F.wave, NGW = F.G * NWAVES;
    constexpr int I_S = 16 * 16;
    constexpr int I_IN = 16 * 112, I_OUT = 16 * 32, I_G = 16 * 8, I_D = 4 * 32;
    constexpr int NITEMS = I_IN + I_OUT + NE * I_G * 2 + NE * I_D;
    for (int it = gw; it < NITEMS; it += NGW) {
        int r = it;
        if (r < I_IN) {
            if (r < I_S)      { tr_item(a.w_in, WIN_LD, 0,    1024, 16, Win_t, PC_MQ, 1, scr, r, lane); continue; } r -= I_S;
            if (r < I_S)      { tr_item(a.w_in, WIN_LD, 3072, 1024, 16, Win_t, PC_GZ, 1, scr, r, lane); continue; } r -= I_S;
            if (r < I_S)      { tr_item(a.w_in, WIN_LD, 512,  1024, 16, Win_t, PC_MK, 1, scr, r, lane); continue; } r -= I_S;
            if (r < I_S)      { tr_item(a.w_in, WIN_LD, 1024, 1024, 16, Win_t, PC_MV, 1, scr, r, lane); continue; } r -= I_S;
            tr_item(a.w_in, WIN_LD, 1536, 1024, 48, Win_t, PC_GQ, 1, scr, r, lane); continue;
        }
        r -= I_IN;
        if (r < I_OUT) { tr_item(a.w_out, 1024, 0, 1024, 32, Wout_t, 0, 1, scr, r, lane); continue; }
        r -= I_OUT;
        if (r < NE * I_G * 2) { const int e = r / (2 * I_G), q = r - e * 2 * I_G, s = q / I_G, ii = q - s * I_G;
            tr_item((s ? a.w_up : a.w_gate) + (size_t)e * 1024 * 256, 256, 0, 1024, 8, Wgu_t, e * 512 + s, 2, scr, ii, lane); continue; }
        r -= NE * I_G * 2;
        { const int e = r / I_D, ii = r - e * I_D; tr_item(a.w_down + (size_t)e * 256 * 1024, 1024, 0, 256, 32, Wd_t, e * 1024, 1, scr, ii, lane); }
    }
    LAS float* W8t = (LAS float*)(F.lds + 73728);
    for (int idx = tid; idx < 8192; idx += NTHREADS) { const int k = idx >> 3, o = idx & 7; W8t[o * 1024 + k] = a.attn_norm[k] * a.w_in[(size_t)k * WIN_LD + 3584 + o]; }
    __syncthreads();
    bf16* hb = (bf16*)(ws + WS_HB); float* gab = (float*)(ws + WS_GAB);
    f32x4 gn[4];
#pragma unroll
    for (int j = 0; j < 4; ++j) gn[j] = ((const f32x4*)a.attn_norm)[64 * j + lane];
    for (int m = gw; m < T; m += NGW) {
        const f32x4* xr = (const f32x4*)(a.x + (size_t)m * D) + lane;
        f32x4 v[4]; float s = 0.f;
#pragma unroll
        for (int j = 0; j < 4; ++j) { v[j] = xr[64 * j]; s += (v[j].x * v[j].x + v[j].y * v[j].y) + (v[j].z * v[j].z + v[j].w * v[j].w); }
        const float rs = 1.0f / sqrtf(wave_sum(s) * (1.f / D) + RMS_EPS);
        uint2* o8 = (uint2*)(hb + (size_t)m * D) + lane;
#pragma unroll
        for (int j = 0; j < 4; ++j) { uint2 o; o.x = pk2(v[j].x * rs * gn[j].x, v[j].y * rs * gn[j].y); o.y = pk2(v[j].z * rs * gn[j].z, v[j].w * rs * gn[j].w); o8[64 * j] = o; }
        float myv = 0.f;
#pragma unroll
        for (int o = 0; o < 8; ++o) { float acc = 0.f;
#pragma unroll
            for (int j = 0; j < 4; ++j) { const f32x4 w = *(const LAS f32x4*)(W8t + o * 1024 + 256 * j + 4 * lane); acc += (v[j].x * w.x + v[j].y * w.y) + (v[j].z * w.z + v[j].w * w.w); }
            acc = wave_sum(acc) * rs; if (lane == o) myv = acc; }
        if (lane < 8) gab[(size_t)m * 8 + lane] = myv;
    }
}

__device__ __forceinline__ void p2_kmean(const Args& a, const Ctx& F) {
    LANE_TID;
    const bf16* P = (const bf16*)(a.ws + WS_P); float* kmean = (float*)(a.ws + WS_KMEAN);
    const int gw = F.bid * NWAVES + F.wave, NGW = F.G * NWAVES;
    for (int it = gw; it < NB * MH * MNB; it += NGW) {
        const int blk = it % MNB, h = (it / MNB) % MH, b = it / (MNB * MH);
        const bf16* kp = P + (size_t)(b * NS + blk * MBLK) * NP + PC_MK + h * MD + lane;
        float s = 0.f;
#pragma unroll 8
        for (int r = 0; r < MBLK; ++r) s += bf2f(kp[(size_t)r * NP]);
        kmean[(size_t)it * MD + lane] = s * (1.f / MBLK);
    }
}

__device__ __forceinline__ void p3_attn_naive(const Args& a, const Ctx& F) {
    LANE_TID;
    bf16* P = (bf16*)(a.ws + WS_P); const float* kmean = (const float*)(a.ws + WS_KMEAN);
    const int gw = F.bid * NWAVES + F.wave, NGW = F.G * NWAVES;
    for (int u = gw; u < NB * MH * (NS / 64); u += NGW) {
        const int qt = u % (NS / 64), h = (u / (NS / 64)) % MH, b = u / ((NS / 64) * MH);
        const int own = qt >> 2, t = qt * 64 + lane;
        const size_t rowbase = (size_t)b * NS;
        bf16* qp = P + (rowbase + t) * NP + PC_MQ + h * MD;
        unsigned qk[32];
#pragma unroll
        for (int i = 0; i < 8; ++i) { const v4u w = ((const v4u*)qp)[i]; qk[4 * i] = w.x; qk[4 * i + 1] = w.y; qk[4 * i + 2] = w.z; qk[4 * i + 3] = w.w; }
        float gate[7];
#pragma unroll
        for (int j = 0; j < 7; ++j) { gate[j] = -INFINITY;
            if (j < own) { const float* km = kmean + ((size_t)((b * MH + h) * MNB + j)) * MD; float s = 0.f;
#pragma unroll
                for (int d = 0; d < 32; ++d) s += bflo(qk[d]) * km[2 * d] + bfhi(qk[d]) * km[2 * d + 1];
                gate[j] = s; } }
        unsigned mask = 0u;
        if (own <= 3) mask = (1u << own) - 1u;
        else {
#pragma unroll
            for (int r = 0; r < 3; ++r) { int best = 0; float bv = -INFINITY;
#pragma unroll
                for (int j = 0; j < 7; ++j) { const bool ok = (j < own) && !((mask >> j) & 1u) && (gate[j] > bv); if (ok) { bv = gate[j]; best = j; } }
                mask |= 1u << best; }
        }
        float o[64];
#pragma unroll
        for (int d = 0; d < 64; ++d) o[d] = 0.f;
        float mrun = -1e30f, lrun = 0.f;
        const bf16* Kb = P + rowbase * NP + PC_MK + h * MD; const bf16* Vb = P + rowbase * NP + PC_MV + h * MD;
        for (int j = 0; j <= own; ++j) {
            const bool isown = (j == own);
            const bool sel = isown || ((mask >> j) & 1u);
            if (__ballot(sel) == 0ull) continue;
            const int nk = isown ? ((qt & 3) * 64 + 64) : MBLK;
#pragma unroll 1
            for (int kk = 0; kk < nk; ++kk) {
                const int key = j * MBLK + kk; const v4u* kp = (const v4u*)(Kb + (size_t)key * NP); float acc = 0.f;
#pragma unroll
                for (int c = 0; c < 8; ++c) { const v4u w = kp[c];
                    acc += bflo(qk[4 * c]) * bflo(w.x) + bfhi(qk[4 * c]) * bfhi(w.x) + bflo(qk[4 * c + 1]) * bflo(w.y) + bfhi(qk[4 * c + 1]) * bfhi(w.y)
                         + bflo(qk[4 * c + 2]) * bflo(w.z) + bfhi(qk[4 * c + 2]) * bfhi(w.z) + bflo(qk[4 * c + 3]) * bflo(w.w) + bfhi(qk[4 * c + 3]) * bfhi(w.w); }
                const bool valid = sel && (!isown || key <= t);
                const float sc = valid ? acc * 0.125f : -1e30f;
                const float mnew = fmaxf(mrun, sc), alpha = __expf(mrun - mnew);
                const float p = valid ? __expf(sc - mnew) : 0.f;
                lrun = lrun * alpha + p; mrun = mnew;
                const v4u* vp = (const v4u*)(Vb + (size_t)key * NP);
#pragma unroll
                for (int c = 0; c < 8; ++c) { const v4u w = vp[c];
                    o[8 * c + 0] = o[8 * c + 0] * alpha + p * bflo(w.x); o[8 * c + 1] = o[8 * c + 1] * alpha + p * bfhi(w.x); o[8 * c + 2] = o[8 * c + 2] * alpha + p * bflo(w.y); o[8 * c + 3] = o[8 * c + 3] * alpha + p * bfhi(w.y);
                    o[8 * c + 4] = o[8 * c + 4] * alpha + p * bflo(w.z); o[8 * c + 5] = o[8 * c + 5] * alpha + p * bfhi(w.z); o[8 * c + 6] = o[8 * c + 6] * alpha + p * bflo(w.w); o[8 * c + 7] = o[8 * c + 7] * alpha + p * bfhi(w.w); }
            }
        }
        const float inv = 1.f / lrun;
#pragma unroll
        for (int i = 0; i < 8; ++i) { v4u w; w.x = pk2(o[8 * i] * inv, o[8 * i + 1] * inv); w.y = pk2(o[8 * i + 2] * inv, o[8 * i + 3] * inv); w.z = pk2(o[8 * i + 4] * inv, o[8 * i + 5] * inv); w.w = pk2(o[8 * i + 6] * inv, o[8 * i + 7] * inv);
            ((v4u*)qp)[i] = w; }
    }
}

__device__ __forceinline__ void p3_gdn_naive(const Args& a, const Ctx& F) {
    LANE_TID;
    bf16* P = (bf16*)(a.ws + WS_P); const float* gab = (const float*)(a.ws + WS_GAB);
    LAS float* red = (LAS float*)(F.lds);
    LAS float* red2 = red + 16;
    LAS float* qs = red + 32;
    LAS float* ks = qs + 512;
    const int h = tid >> 7, c = tid & 127, wv = (tid >> 6) & 1;
    for (int b = F.bid; b < NB; b += F.G) {
        float S[128];
#pragma unroll
        for (int k = 0; k < 128; ++k) S[k] = 0.f;
        float xq0 = 0.f, xq1 = 0.f, xq2 = 0.f, xk0 = 0.f, xk1 = 0.f, xk2 = 0.f, xv0 = 0.f, xv1 = 0.f, xv2 = 0.f;
        float cq[4], ck[4], cv[4];
#pragma unroll
        for (int i = 0; i < 4; ++i) { cq[i] = a.conv_w[i * 1536 + h * 128 + c]; ck[i] = a.conv_w[i * 1536 + 512 + h * 128 + c]; cv[i] = a.conv_w[i * 1536 + 1024 + h * 128 + c]; }
        const float negA = -__expf(a.A_log[h]), dtb = a.dt_bias[h], gnorm = a.gdn_norm[c];
        for (int t = 0; t < NS; ++t) {
            const size_t row = (size_t)b * NS + t;
            bf16* pr = P + row * NP;
            const float xq3 = bf2f(pr[PC_GQ + h * 128 + c]), xk3 = bf2f(pr[PC_GK + h * 128 + c]), xv3 = bf2f(pr[PC_GV + h * 128 + c]);
            const float gz = bf2f(pr[PC_GZ + h * 128 + c]);
            const float ga = gab[row * 8 + h], gb = gab[row * 8 + 4 + h];
            const float qv = siluf(cq[0] * xq0 + cq[1] * xq1 + cq[2] * xq2 + cq[3] * xq3);
            const float kv = siluf(ck[0] * xk0 + ck[1] * xk1 + ck[2] * xk2 + ck[3] * xk3);
            const float vv = siluf(cv[0] * xv0 + cv[1] * xv1 + cv[2] * xv2 + cv[3] * xv3);
            xq0 = xq1; xq1 = xq2; xq2 = xq3; xk0 = xk1; xk1 = xk2; xk2 = xk3; xv0 = xv1; xv1 = xv2; xv2 = xv3;
            const float sq = wave_sum(qv * qv), sk = wave_sum(kv * kv);
            if (lane == 0) { red[(h * 2 + wv) * 2 + 0] = sq; red[(h * 2 + wv) * 2 + 1] = sk; }
            __syncthreads();
            const float ssq = red[(h * 2 + 0) * 2 + 0] + red[(h * 2 + 1) * 2 + 0], ssk = red[(h * 2 + 0) * 2 + 1] + red[(h * 2 + 1) * 2 + 1];
            const float nq = (1.0f / sqrtf(ssq + 1e-6f)) * 0.08838834764831845f, nk = 1.0f / sqrtf(ssk + 1e-6f);
            qs[h * 128 + c] = qv * nq; ks[h * 128 + c] = kv * nk;
            __syncthreads();
            const float xsp = ga + dtb; const float sp = xsp > 20.f ? xsp : log1pf(__expf(xsp));
            const float g = negA * sp, ea = __expf(g), beta = 1.f / (1.f + __expf(-gb));
            float kTS = 0.f;
#pragma unroll
            for (int k4 = 0; k4 < 32; ++k4) { const f32x4 kk = *(const LAS f32x4*)(ks + h * 128 + 4 * k4);
                kTS += kk.x * S[4 * k4] + kk.y * S[4 * k4 + 1] + kk.z * S[4 * k4 + 2] + kk.w * S[4 * k4 + 3];
                if ((k4 & 3) == 3) asm volatile("" ::: "memory"); }
            const float uu = beta * (vv - ea * kTS);
            float ov = 0.f;
#pragma unroll
            for (int k4 = 0; k4 < 32; ++k4) { const f32x4 kk = *(const LAS f32x4*)(ks + h * 128 + 4 * k4); const f32x4 qq = *(const LAS f32x4*)(qs + h * 128 + 4 * k4);
                S[4 * k4] = ea * S[4 * k4] + kk.x * uu; ov += qq.x * S[4 * k4];
                S[4 * k4 + 1] = ea * S[4 * k4 + 1] + kk.y * uu; ov += qq.y * S[4 * k4 + 1];
                S[4 * k4 + 2] = ea * S[4 * k4 + 2] + kk.z * uu; ov += qq.z * S[4 * k4 + 2];
                S[4 * k4 + 3] = ea * S[4 * k4 + 3] + kk.w * uu; ov += qq.w * S[4 * k4 + 3];
                if ((k4 & 3) == 3) asm volatile("" ::: "memory"); }
            const float so = wave_sum(ov * ov);
            if (lane == 0) red2[h * 2 + wv] = so;
            __syncthreads();
            const float rso = 1.0f / sqrtf((red2[h * 2] + red2[h * 2 + 1]) * (1.f / 128.f) + RMS_EPS);
            const float y = ov * rso * gnorm * siluf(gz);
            pr[PC_GZ + h * 128 + c] = (bf16)f2bf(y);
        }
        __syncthreads();
    }
}

__device__ __forceinline__ void p5_router(const Args& a, const Ctx& F) {
    LANE_TID;
    unsigned char* ws = a.ws;
    const float* x1 = a.out; bf16* hb = (bf16*)(ws + WS_HB);
    int* tok_e = (int*)(ws + WS_TOKE); float* tok_w = (float*)(ws + WS_TOKW); int* tok_r = (int*)(ws + WS_TOKR);
    unsigned* gcnt = (unsigned*)(ws + WS_CTL) + CW_CNT;
    LAS float* Wr = (LAS float*)(F.lds);
    LAS int* l_e = (LAS int*)(F.lds + 147456);
    LAS int* l_rank = l_e + 256;
    LAS float* l_w = (LAS float*)(l_rank + 256);
    LAS unsigned* lcnt = (LAS unsigned*)(l_w + 256);
    LAS unsigned* gbase = lcnt + 32;
    for (int idx = tid; idx < 4096; idx += NTHREADS) { const int k = idx >> 2, g = idx & 3; Wr[g * 1024 + k] = a.ffn_norm[k] * a.w_group[idx]; }
    for (int idx = tid; idx < 32768; idx += NTHREADS) { const int k = idx >> 5, e = idx & 31; Wr[(4 + e) * 1024 + k] = a.ffn_norm[k] * a.w_router[idx]; }
    f32x4 gn[4];
#pragma unroll
    for (int j = 0; j < 4; ++j) gn[j] = ((const f32x4*)a.ffn_norm)[64 * j + lane];
    for (int chunk = F.bid; chunk < T / 128; chunk += F.G) {
        if (tid < 32) lcnt[tid] = 0u;
        __syncthreads();
        for (int i = 0; i < 16; ++i) {
            const int lr = F.wave * 16 + i, m = chunk * 128 + lr;
            const f32x4* xr = (const f32x4*)(x1 + (size_t)m * D) + lane;
            f32x4 v[4]; float s = 0.f;
#pragma unroll
            for (int j = 0; j < 4; ++j) { v[j] = xr[64 * j]; s += (v[j].x * v[j].x + v[j].y * v[j].y) + (v[j].z * v[j].z + v[j].w * v[j].w); }
            const float rs = 1.0f / sqrtf(wave_sum(s) * (1.f / D) + RMS_EPS);
            uint2* o8 = (uint2*)(hb + (size_t)m * D) + lane;
#pragma unroll
            for (int j = 0; j < 4; ++j) { uint2 o; o.x = pk2(v[j].x * rs * gn[j].x, v[j].y * rs * gn[j].y); o.y = pk2(v[j].z * rs * gn[j].z, v[j].w * rs * gn[j].w); o8[64 * j] = o; }
            float lg[36];
#pragma unroll
            for (int o = 0; o < 36; ++o) { float acc = 0.f;
#pragma unroll
                for (int j = 0; j < 4; ++j) { const f32x4 w = *(const LAS f32x4*)(Wr + o * 1024 + 256 * j + 4 * lane); acc += (v[j].x * w.x + v[j].y * w.y) + (v[j].z * w.z + v[j].w * w.w); }
                lg[o] = wave_sum(acc) * rs; }
            int gs = 0; float gmax = lg[0];
#pragma unroll
            for (int g = 1; g < 4; ++g) if (lg[g] > gmax) { gmax = lg[g]; gs = g; }
            float gden = 0.f;
#pragma unroll
            for (int g = 0; g < 4; ++g) gden += __expf(lg[g] - gmax);
            const float pgrp = 1.f / gden;
            float il[8];
#pragma unroll
            for (int e = 0; e < 8; ++e) { float vsel = lg[4 + e];
#pragma unroll
                for (int g = 1; g < 4; ++g) vsel = (gs == g) ? lg[4 + 8 * g + e] : vsel;
                il[e] = vsel; }
            int i0 = 0; float m0 = il[0];
#pragma unroll
            for (int e = 1; e < 8; ++e) if (il[e] > m0) { m0 = il[e]; i0 = e; }
            int i1 = -1; float m1 = -INFINITY;
#pragma unroll
            for (int e = 0; e < 8; ++e) if (e != i0 && il[e] > m1) { m1 = il[e]; i1 = e; }
            const float e1 = __expf(m1 - m0), w0 = pgrp / (1.f + e1), w1 = pgrp * e1 / (1.f + e1);
            if (lane == 0) {
                const int ex0 = gs * 8 + i0, ex1 = gs * 8 + i1;
                l_e[lr * 2] = ex0; l_e[lr * 2 + 1] = ex1; l_w[lr * 2] = w0; l_w[lr * 2 + 1] = w1;
                l_rank[lr * 2] = (int)atomicAdd((unsigned*)&lcnt[ex0], 1u); l_rank[lr * 2 + 1] = (int)atomicAdd((unsigned*)&lcnt[ex1], 1u);
            }
        }
        __syncthreads();
        if (tid < 32) gbase[tid] = __hip_atomic_fetch_add(gcnt + tid, lcnt[tid], __ATOMIC_RELAXED, __HIP_MEMORY_SCOPE_AGENT);
        __syncthreads();
        if (tid < 256) { const int m2 = chunk * 256 + tid; const int e = l_e[tid];
            tok_e[m2] = e; tok_w[m2] = l_w[tid]; tok_r[m2] = (int)gbase[e] + l_rank[tid]; }
        __syncthreads();
    }
}

__device__ __forceinline__ void p6_gather(const Args& a, const Ctx& F) {
    LANE_TID;
    unsigned char* ws = a.ws;
    const bf16* hb = (const bf16*)(ws + WS_HB); bf16* xs = (bf16*)(ws + WS_XS);
    const int* tok_e = (const int*)(ws + WS_TOKE); const float* tok_w = (const float*)(ws + WS_TOKW); const int* tok_r = (const int*)(ws + WS_TOKR);
    int* rowmap = (int*)(ws + WS_ROWMAP); float* roww = (float*)(ws + WS_ROWW); int* tile_e = (int*)(ws + WS_TILEE);
    const unsigned* gcnt = (const unsigned*)(ws + WS_CTL) + CW_CNT; unsigned* ntw = (unsigned*)(ws + WS_CTL) + CW_NT;
    LAS int* off = (LAS int*)(F.lds);
    LAS int* cntl = off + 64;
    if (tid == 0) { int o = 0;
        for (int e = 0; e < NE; ++e) { const int c = (int)__hip_atomic_load(gcnt + e, __ATOMIC_RELAXED, __HIP_MEMORY_SCOPE_AGENT); off[e] = o; cntl[e] = c; o += ((c + 255) >> 8) << 8; }
        off[NE] = o; }
    __syncthreads();
    if (F.bid == 0) {
        const int nt = off[NE] >> 8;
        if (tid == 0) __hip_atomic_store(ntw, (unsigned)nt, __ATOMIC_RELAXED, __HIP_MEMORY_SCOPE_AGENT);
        for (int mt = tid; mt < nt; mt += NTHREADS) { int e = 0;
            for (int k = 1; k < NE; ++k) if (off[k] <= mt * 256) e = k;
            tile_e[mt] = e; }
        for (int e = 0; e < NE; ++e) for (int r = off[e] + cntl[e] + tid; r < off[e + 1]; r += NTHREADS) { rowmap[r] = 2 * T; roww[r] = 0.f; }
    }
    const int gw = F.bid * NWAVES + F.wave, NGW = F.G * NWAVES;
    for (int p = gw; p < 2 * T; p += NGW) {
        const int e = tok_e[p], r = off[e] + tok_r[p], t = p >> 1;
        const v4u* src = (const v4u*)(hb + (size_t)t * D); v4u* dst = (v4u*)(xs + (size_t)r * D);
        const v4u w0 = src[lane], w1 = src[64 + lane];
        dst[lane] = w0; dst[64 + lane] = w1;
        if (lane == 0) { rowmap[r] = p; roww[r] = tok_w[p]; }
    }
}

__device__ __forceinline__ void p9_final(const Args& a, const Ctx& F) {
    LANE_TID;
    const bf16* y2 = (const bf16*)(a.ws + WS_Y2);
    const int gw = F.bid * NWAVES + F.wave, NGW = F.G * NWAVES;
    f32x4 gn[4];
#pragma unroll
    for (int j = 0; j < 4; ++j) gn[j] = ((const f32x4*)a.final_norm)[64 * j + lane];
    for (int m = gw; m < T; m += NGW) {
        f32x4* xr = (f32x4*)(a.out + (size_t)m * D) + lane;
        const uint2* ya = (const uint2*)(y2 + (size_t)(2 * m) * D) + lane; const uint2* yb = (const uint2*)(y2 + (size_t)(2 * m + 1) * D) + lane;
        f32x4 v[4]; float s = 0.f;
#pragma unroll
        for (int j = 0; j < 4; ++j) { v[j] = xr[64 * j]; const uint2 p = ya[64 * j], q = yb[64 * j];
            v[j].x += bflo(p.x) + bflo(q.x); v[j].y += bfhi(p.x) + bfhi(q.x); v[j].z += bflo(p.y) + bflo(q.y); v[j].w += bfhi(p.y) + bfhi(q.y);
            s += (v[j].x * v[j].x + v[j].y * v[j].y) + (v[j].z * v[j].z + v[j].w * v[j].w); }
        const float rs = 1.0f / sqrtf(wave_sum(s) * (1.f / D) + RMS_EPS);
#pragma unroll
        for (int j = 0; j < 4; ++j) { f32x4 o; o.x = v[j].x * rs * gn[j].x; o.y = v[j].y * rs * gn[j].y; o.z = v[j].z * rs * gn[j].z; o.w = v[j].w * rs * gn[j].w; xr[64 * j] = o; }
    }
}

#ifndef MK_ONE_LAUNCH
#define MK_ONE_LAUNCH 1
#endif
constexpr int N_PHASES = 10;
__global__ void __launch_bounds__(NTHREADS, 2) mega_fwd(Args a) {
    extern __shared__ __attribute__((aligned(16))) unsigned char lds_raw[];
    Ctx F; F.lds = (LAS unsigned char*)lds_raw; F.wave = __builtin_amdgcn_readfirstlane((int)(threadIdx.x >> 6)); F.G = gridDim.x; F.bid = blockIdx.x;
    const int lo = a.ph_lo, hi = a.ph_hi;
    unsigned char* ws = a.ws;
#ifndef PH_MASK
#define PH_MASK 0x3ff
#endif
#define IN(k) (((PH_MASK >> (k)) & 1) && lo <= (k) && (k) < hi)
#if MK_ONE_LAUNCH
    XcdBarrier bar;
    {
        const int lane0 = lane_id(); const bool leader0 = (F.wave == 0 && lane0 == 0);
        if (F.wave == 0) ((LAS unsigned*)(F.lds + LDS_CTL_OFF))[lane0] = 0u;
        __syncthreads();
        bar = xcd_barrier_post((unsigned*)(ws + WS_CTL) + CW_BAR, (volatile LAS unsigned*)(F.lds + LDS_CTL_OFF), leader0);
        cg::this_grid().sync();
    }
#define SEAM(k) do { if (IN(k) && IN((k) + 1)) { const bool leader_ = (F.wave == 0 && lane_id() == 0); xcd_barrier(bar, leader_, (unsigned)F.G); } } while (0)
#else
#define SEAM(k) do { } while (0)
#endif
    if (IN(0)) p0_prologue(a, F);
    SEAM(0);
    if (IN(1)) {
        pg8::Gemm g{(const pg8::bf16_t*)(ws + WS_HB), (const pg8::bf16_t*)(ws + WS_WIN), D, D};
        pg8::StaticOrder S; S.init(T, NP, F.G, F.bid);
        pg8::EpiStoreBf16 E{(pg8::bf16_t*)(ws + WS_P), NP, 0, 1.f};
        pg8::gemm_phase<pg8::EpiStoreBf16, pg8::StaticOrder, true, true>(F.lds, g, S, E, F.wave);
    }
    SEAM(1);
    if (IN(2)) p2_kmean(a, F);
    SEAM(2);
    if (IN(3)) { p3_gdn_naive(a, F); p3_attn_naive(a, F); }
    SEAM(3);
    if (IN(4)) {
        pg8::Gemm g{(const pg8::bf16_t*)(ws + WS_P), (const pg8::bf16_t*)(ws + WS_WOUT), NP, D};
        pg8::StaticOrder S; S.init(T, D, F.G, F.bid);
        pg8::EpiResF32 E{a.x, a.out, D};
        pg8::gemm_phase<pg8::EpiResF32, pg8::StaticOrder, true, true>(F.lds, g, S, E, F.wave);
    }
    SEAM(4);
    if (IN(5)) p5_router(a, F);
    SEAM(5);
    if (IN(6)) p6_gather(a, F);
    SEAM(6);
    if (IN(7)) {
        const int nt = (int)__hip_atomic_load((const unsigned*)(ws + WS_CTL) + CW_NT, __ATOMIC_RELAXED, __HIP_MEMORY_SCOPE_AGENT);
        pg8::Gemm g{(const pg8::bf16_t*)(ws + WS_XS), (const pg8::bf16_t*)(ws + WS_WGU), D, D};
        pg8::MoeOrder S{(const int*)(ws + WS_TILEE), nt, 2, F.G, F.bid};
        pg8::EpiGateUp E{(pg8::bf16_t*)(ws + WS_HID), (const float*)(ws + WS_ROWW)};
        pg8::gemm_phase<pg8::EpiGateUp, pg8::MoeOrder, true, true>(F.lds, g, S, E, F.wave);
    }
    SEAM(7);
    if (IN(8)) {
        const int nt = (int)__hip_atomic_load((const unsigned*)(ws + WS_CTL) + CW_NT, __ATOMIC_RELAXED, __HIP_MEMORY_SCOPE_AGENT);
        pg8::Gemm g{(const pg8::bf16_t*)(ws + WS_HID), (const pg8::bf16_t*)(ws + WS_WD), FF, FF};
        pg8::MoeOrder S{(const int*)(ws + WS_TILEE), nt, 4, F.G, F.bid};
        pg8::EpiDown E{(pg8::bf16_t*)(ws + WS_Y2), (const int*)(ws + WS_ROWMAP)};
        pg8::gemm_phase<pg8::EpiDown, pg8::MoeOrder, true, true>(F.lds, g, S, E, F.wave);
    }
    SEAM(8);
    if (IN(9)) p9_final(a, F);
#undef IN
#undef SEAM
}

extern "C" void kernel_launch(void* const* d_in, const int* in_sizes, int n_in, void* d_out, int out_size, void* d_ws, size_t ws_size, hipStream_t stream) {
    static int grid = 0;
    if (grid == 0) {
        int dev = 0, cus = 0, per_cu = 0;
        hipGetDevice(&dev); hipDeviceGetAttribute(&cus, hipDeviceAttributeMultiprocessorCount, dev);
        hipFuncSetAttribute((const void*)mega_fwd, hipFuncAttributeMaxDynamicSharedMemorySize, LDS_BYTES);
        hipOccupancyMaxActiveBlocksPerMultiprocessor(&per_cu, (const void*)mega_fwd, NTHREADS, LDS_BYTES);
        if (per_cu < 1) { fprintf(stderr, "kernel_launch: occupancy query says %d blocks/CU\n", per_cu); per_cu = 1; }
        grid = cus * 1;
        if (ws_size < WS_END) { fprintf(stderr, "kernel_launch: workspace too small (%zu < %zu)\n", ws_size, (size_t)WS_END); grid = -1; }
    }
    if (grid < 0) return;
    hipMemsetAsync((char*)d_ws + WS_CTL, 0, CTL_ZERO_BYTES, stream);
    Args a{};
    a.x = (const float*)d_in[0]; a.attn_norm = (const float*)d_in[1]; a.w_in = (const float*)d_in[2]; a.conv_w = (const float*)d_in[3]; a.A_log = (const float*)d_in[4];
    a.dt_bias = (const float*)d_in[5]; a.gdn_norm = (const float*)d_in[6]; a.w_out = (const float*)d_in[7]; a.ffn_norm = (const float*)d_in[8]; a.w_group = (const float*)d_in[9];
    a.w_router = (const float*)d_in[10]; a.w_gate = (const float*)d_in[11]; a.w_up = (const float*)d_in[12]; a.w_down = (const float*)d_in[13]; a.final_norm = (const float*)d_in[14];
    a.out = (float*)d_out; a.ws = (unsigned char*)d_ws;
#if MK_ONE_LAUNCH
    a.ph_lo = 0; a.ph_hi = N_PHASES;
    void* args[] = {&a};
    hipError_t e = hipLaunchCooperativeKernel((const void*)mega_fwd, dim3(grid), dim3(NTHREADS), args, LDS_BYTES, stream);
    if (e != hipSuccess) fprintf(stderr, "cooperative launch failed: %s (grid %d)\n", hipGetErrorString(e), grid);
#else
    for (int p = 0; p < N_PHASES; ++p) { a.ph_lo = p; a.ph_hi = p + 1; hipLaunchKernelGGL(mega_fwd, dim3(grid), dim3(NTHREADS), LDS_BYTES, stream, a); }
#endif
}
```

```cpp
#include <hip/hip_runtime.h>
#include <hip/hip_cooperative_groups.h>
#include <cstdio>
#include <cstdint>
namespace cg = cooperative_groups;
__device__ __forceinline__ int lane_id_opaque() { int l; asm volatile("v_mbcnt_lo_u32_b32 %0, -1, 0\n\tv_mbcnt_hi_u32_b32 %0, -1, %0" : "=v"(l)); return l; }
namespace pg8 {
#define PG8_LAS __attribute__((address_space(3)))
typedef unsigned short bf16_t;
typedef short bf16x8 __attribute__((ext_vector_type(8)));
typedef float f32x4 __attribute__((ext_vector_type(4)));
typedef unsigned u32x4 __attribute__((ext_vector_type(4)));
constexpr int BM = 256, BK = 64, HALF = 128, HTB = HALF * BK * 2  , STAGE_BYTES = 8 * HTB, NXCD = 8, WGM = 8;

__host__ __device__ __forceinline__ int lds_byte(int r, int c) { const int st = (r >> 4) * 2 + (c >> 5), rr = r & 15, cc = c & 31, ob = rr * 64 + cc * 2; return st * 1024 + (ob ^ (((ob >> 9) & 1) << 5)); }
__host__ __device__ __forceinline__ void stage_rc(int b, int& R, int& C) { const int st = b / 1024, sb = b % 1024, swz = sb ^ (((sb >> 9) & 1) << 5); R = (st >> 1) * 16 + swz / 64; C = (st & 1) * 32 + (swz % 64) / 2; }
__host__ __device__ __forceinline__ int perm32(int rho) { const int n = rho >> 4, i = rho & 15; return 8 * (i >> 2) + 4 * n + (i & 3); }

struct Unit { int pm, pn; };
struct Gemm { const bf16_t* A; const bf16_t* Bt; int lda, K; };

struct StaticOrder {
    int nM, nN, nwg, G, c;
    __host__ __device__ void init(int M, int N, int G_, int c_) { nM = M / BM; nN = N / BM; nwg = nM * nN; G = G_; c = c_; }
    __host__ __device__ bool next(int i, Unit& u) const {
        const long L = (long)i * G + c; if (L >= nwg) return false;
        int wgid = (int)L; { const int q = nwg / NXCD, r = nwg % NXCD, xcd = wgid % NXCD, off = wgid / NXCD; wgid = (xcd < r ? xcd * (q + 1) : r * (q + 1) + (xcd - r) * q) + off; }
        const int nig = WGM * nN, gid = wgid / nig, fm = gid * WGM, gsz = (nM - fm) < WGM ? (nM - fm) : WGM;
        u.pm = fm + ((wgid % nig) % gsz); u.pn = (wgid % nig) / gsz; return true;
    }
    __device__ __forceinline__ void a_ready(const Unit&) const {}
    __device__ __forceinline__ void done(const Unit&) const {}
};

__device__ __forceinline__ unsigned cvt_pk_bf16(float lo, float hi) { unsigned r; asm volatile("v_cvt_pk_bf16_f32 %0, %1, %2" : "=v"(r) : "v"(lo), "v"(hi)); return r; }

struct EpiStoreBf16 {
    static constexpr bool PERM = true, AFTER_DRAIN = false;
    bf16_t* O; int ldc; int scale_cols; float scale0;
    __device__ __forceinline__ void operator()(const f32x4 (&acc)[2][2][4][2], const Unit& u, int wr, int wc, int fr, int fq) const {
        const int row0 = u.pm * BM + wr * 64 + fr; const int colt = u.pn * BM;
        const float sc = (colt < scale_cols) ? scale0 : 1.f;
        const int col0 = colt + wc * 32 + 8 * fq;
#pragma unroll
        for (int ai = 0; ai < 2; ++ai)
#pragma unroll
            for (int m = 0; m < 4; ++m) { bf16_t* rowp = O + (size_t)(row0 + ai * HALF + m * 16) * ldc + col0;
#pragma unroll
                for (int bj = 0; bj < 2; ++bj) { const f32x4 v0 = acc[ai][bj][m][0] * sc, v1 = acc[ai][bj][m][1] * sc;
                    u32x4 w; w.x = cvt_pk_bf16(v0[0], v0[1]); w.y = cvt_pk_bf16(v0[2], v0[3]); w.z = cvt_pk_bf16(v1[0], v1[1]); w.w = cvt_pk_bf16(v1[2], v1[3]);
                    *(u32x4*)(rowp + bj * HALF) = w; } }
    }
};
struct EpiResF32 {
    static constexpr bool PERM = false, AFTER_DRAIN = false;
    const float* base; float* out; int ldc;
    __device__ __forceinline__ void operator()(const f32x4 (&acc)[2][2][4][2], const Unit& u, int wr, int wc, int fr, int fq) const {
        const int row0 = u.pm * BM + wr * 64 + fr, col0 = u.pn * BM + wc * 32 + 4 * fq;
#pragma unroll
        for (int ai = 0; ai < 2; ++ai)
#pragma unroll
            for (int m = 0; m < 4; ++m) { const size_t off = (size_t)(row0 + ai * HALF + m * 16) * ldc + col0;
#pragma unroll
                for (int bj = 0; bj < 2; ++bj)
#pragma unroll
                    for (int n = 0; n < 2; ++n) { const f32x4 b = *(const f32x4*)(base + off + bj * HALF + n * 16); *(f32x4*)(out + off + bj * HALF + n * 16) = b + acc[ai][bj][m][n]; } }
    }
};
struct EpiGateUp {
    static constexpr bool PERM = true, AFTER_DRAIN = false;
    bf16_t* hid; const float* roww;
    __device__ __forceinline__ void operator()(const f32x4 (&acc)[2][2][4][2], const Unit& u, int wr, int wc, int fr, int fq) const {
        const int row0 = u.pm * BM + wr * 64 + fr; const int hc0 = (u.pn & 1) * 128 + 16 * wc + 4 * fq;
#pragma unroll
        for (int ai = 0; ai < 2; ++ai)
#pragma unroll
            for (int m = 0; m < 4; ++m) { const int r = row0 + ai * HALF + m * 16; const float w = roww[r]; bf16_t* rowp = hid + (size_t)r * 256 + hc0;
#pragma unroll
                for (int bj = 0; bj < 2; ++bj) { const f32x4 v0 = acc[ai][bj][m][0], v1 = acc[ai][bj][m][1];
                    const float h0 = v0[0] / (1.f + __expf(-v0[0])) * v0[1] * w, h1 = v0[2] / (1.f + __expf(-v0[2])) * v0[3] * w;
                    const float h2 = v1[0] / (1.f + __expf(-v1[0])) * v1[1] * w, h3 = v1[2] / (1.f + __expf(-v1[2])) * v1[3] * w;
                    uint2 o; o.x = cvt_pk_bf16(h0, h1); o.y = cvt_pk_bf16(h2, h3);
                    *(uint2*)(rowp + bj * 64) = o; } }
    }
};
struct EpiDown {
    static constexpr bool PERM = true, AFTER_DRAIN = false;
    bf16_t* y2; const int* rowmap;
    __device__ __forceinline__ void operator()(const f32x4 (&acc)[2][2][4][2], const Unit& u, int wr, int wc, int fr, int fq) const {
        const int row0 = u.pm * BM + wr * 64 + fr; const int col0 = (u.pn & 3) * 256 + wc * 32 + 8 * fq;
#pragma unroll
        for (int ai = 0; ai < 2; ++ai)
#pragma unroll
            for (int m = 0; m < 4; ++m) { int r = row0 + ai * HALF + m * 16; asm volatile("" : "+v"(r)); const int dst = rowmap[r];
                bf16_t* rowp = y2 + (size_t)dst * 1024 + col0;
#pragma unroll
                for (int bj = 0; bj < 2; ++bj) { const f32x4 v0 = acc[ai][bj][m][0], v1 = acc[ai][bj][m][1];
                    u32x4 w; w.x = cvt_pk_bf16(v0[0], v0[1]); w.y = cvt_pk_bf16(v0[2], v0[3]); w.z = cvt_pk_bf16(v1[0], v1[1]); w.w = cvt_pk_bf16(v1[2], v1[3]);
                    *(u32x4*)(rowp + bj * HALF) = w; } }
    }
};
struct MoeOrder {
    const int* tile_e; int ntiles, nsub, G, c;
    __device__ __forceinline__ bool next(int i, Unit& u) const {
        const int L = i * G + c; if (L >= ntiles * nsub) return false;
        const int mt = L / nsub, j = L - mt * nsub; u.pm = mt; u.pn = tile_e[mt] * nsub + j; return true;
    }
    __device__ __forceinline__ void a_ready(const Unit&) const {}
    __device__ __forceinline__ void done(const Unit&) const {}
};

template <class Epi, class Sched, bool ALIGN_EPI = false, bool SP2 = false>
__device__ __forceinline__ void gemm_phase(PG8_LAS unsigned char* lds, const Gemm g, const Sched& S, const Epi& E, const int wid) {
    const int lane = lane_id_opaque(), tid = wid * 64 + lane, wr = wid >> 2, wc = wid & 3, fr = lane & 15, fq = lane >> 4;
    const int K = g.K, nt = K / BK, lda = g.lda;
    unsigned voffA[2], voffB[2];
#pragma unroll
    for (int i = 0; i < 2; ++i) { int R, C; stage_rc(tid * 16 + i * 8192, R, C); const int Rb = Epi::PERM ? ((R & ~31) + perm32(R & 31)) : R;
        voffA[i] = (unsigned)(R * lda + C) * 2u; voffB[i] = (unsigned)(Rb * K + C) * 2u; }
    const size_t kstep = (size_t)(BK * 2);
    const size_t hstepA = (size_t)HALF * lda * 2, hstepB = (size_t)HALF * K * 2;
    const size_t tstepA = 2 * hstepA, tstepB = 2 * hstepB;
    const unsigned ldsw = (unsigned)wid * 1024u;
    const int aoff = lds_byte(wr * 64 + fr, fq * 8), boff = lds_byte(wc * 32 + fr, fq * 8);
#define PG8_SA(b, h) (((b) * 2 + (h)) * HTB)
#define PG8_SB(b, h) ((4 + (b) * 2 + (h)) * HTB)
#define PG8_STAGE(bufoff, gbase, voff) do { _Pragma("unroll") for (int _i = 0; _i < 2; ++_i) \
        __builtin_amdgcn_global_load_lds((const unsigned*)((const char*)(gbase) + (voff)[_i]), (PG8_LAS unsigned*)(lds + (bufoff) + ldsw + _i * 8192), 16, 0, 0); } while (0)
#define PG8_LDA(dst, b, h) do { _Pragma("unroll") for (int m = 0; m < 4; ++m) _Pragma("unroll") for (int k = 0; k < 2; ++k) dst[m][k] = *(const PG8_LAS bf16x8*)(lds + PG8_SA(b, h) + aoff + m * 2048 + k * 1024); } while (0)
#define PG8_LDB(dst, b, h) do { _Pragma("unroll") for (int n = 0; n < 2; ++n) _Pragma("unroll") for (int k = 0; k < 2; ++k) dst[n][k] = *(const PG8_LAS bf16x8*)(lds + PG8_SB(b, h) + boff + n * 2048 + k * 1024); } while (0)
#define PG8_MMA(ai, bj, At, Bt) do { __builtin_amdgcn_s_setprio(1); _Pragma("unroll") for (int m = 0; m < 4; ++m) _Pragma("unroll") for (int n = 0; n < 2; ++n) _Pragma("unroll") for (int k = 0; k < 2; ++k) \
        acc[ai][bj][m][n] = __builtin_amdgcn_mfma_f32_16x16x32_bf16(Bt[n][k], At[m][k], acc[ai][bj][m][n], 0, 0, 0); __builtin_amdgcn_s_setprio(0); } while (0)
#define PG8_WAIT_V(n) asm volatile("s_waitcnt vmcnt(" #n ")" ::: "memory")
#define PG8_WAIT_L(n) asm volatile("s_waitcnt lgkmcnt(" #n ")" ::: "memory")
#define PG8_BAR __builtin_amdgcn_s_barrier()
#define PG8_SCHED __builtin_amdgcn_sched_barrier(0)
    Unit cur, nxt; int ui = 0;
    if (!S.next(0, cur)) return;
    f32x4 acc[2][2][4][2];
#pragma unroll
    for (int a = 0; a < 2; ++a)
#pragma unroll
        for (int b = 0; b < 2; ++b)
#pragma unroll
            for (int m = 0; m < 4; ++m)
#pragma unroll
                for (int n = 0; n < 2; ++n) acc[a][b][m][n] = (f32x4){0.f, 0.f, 0.f, 0.f};
    bf16x8 At[4][2], B0[2][2], B1[2][2];
    const char* cA = (const char*)g.A + (size_t)cur.pm * tstepA; const char* cB = (const char*)g.Bt + (size_t)cur.pn * tstepB;
    S.a_ready(cur);
    if constexpr (SP2) {
        PG8_STAGE(PG8_SB(0, 0), cB, voffB); PG8_STAGE(PG8_SB(0, 1), cB + hstepB, voffB); PG8_STAGE(PG8_SA(0, 0), cA, voffA); PG8_STAGE(PG8_SA(0, 1), cA + hstepA, voffA);
        if (wr == 1) PG8_BAR;
        PG8_WAIT_V(2); PG8_BAR;
        PG8_STAGE(PG8_SB(1, 0), cB + kstep, voffB); PG8_STAGE(PG8_SA(1, 0), cA + kstep, voffA); PG8_STAGE(PG8_SB(1, 1), cB + hstepB + kstep, voffB);
        PG8_WAIT_V(6); PG8_BAR;
    } else {
        PG8_STAGE(PG8_SB(0, 0), cB, voffB); PG8_STAGE(PG8_SA(0, 0), cA, voffA); PG8_STAGE(PG8_SB(0, 1), cB + hstepB, voffB); PG8_STAGE(PG8_SA(0, 1), cA + hstepA, voffA);
        if (wr == 1) PG8_BAR;
        PG8_WAIT_V(4); PG8_BAR;
        PG8_STAGE(PG8_SB(1, 0), cB + kstep, voffB); PG8_STAGE(PG8_SA(1, 0), cA + kstep, voffA); PG8_STAGE(PG8_SB(1, 1), cB + hstepB + kstep, voffB);
        PG8_WAIT_V(6); PG8_BAR;
    }
    for (;;) {
        const bool has_next = S.next(ui + 1, nxt);
        const char* nA = has_next ? (const char*)g.A + (size_t)nxt.pm * tstepA : cA; const char* nB = has_next ? (const char*)g.Bt + (size_t)nxt.pn * tstepB : cB;
        for (int t = 0; t < nt; t += 2) {
            const bool last = (t == nt - 2);
            const char* a1 = cA + (size_t)(t + 1) * kstep;
            const char* a2 = last ? nA : cA + (size_t)(t + 2) * kstep; const char* b2 = last ? nB : cB + (size_t)(t + 2) * kstep;
            const char* a3 = a2 + kstep; const char* b3 = b2 + kstep;
            if (last && has_next) S.a_ready(nxt);
            if constexpr (SP2) {
            PG8_LDB(B0, 0, 0); PG8_LDB(B1, 0, 1); PG8_SCHED; PG8_LDA(At, 0, 0); PG8_STAGE(PG8_SA(1, 1), a1 + hstepA, voffA);
            PG8_WAIT_V(8); PG8_WAIT_L(0); PG8_BAR; PG8_MMA(0, 0, At, B0); PG8_MMA(0, 1, At, B1); PG8_BAR; PG8_SCHED;
            PG8_LDA(At, 0, 1); PG8_STAGE(PG8_SB(0, 0), b2, voffB); PG8_STAGE(PG8_SB(0, 1), b2 + hstepB, voffB); PG8_STAGE(PG8_SA(0, 0), a2, voffA);
            PG8_WAIT_V(8); PG8_WAIT_L(0); PG8_BAR; PG8_MMA(1, 0, At, B0); PG8_MMA(1, 1, At, B1); PG8_BAR; PG8_SCHED;
            PG8_LDB(B0, 1, 0); PG8_LDB(B1, 1, 1); PG8_SCHED; PG8_LDA(At, 1, 0); PG8_STAGE(PG8_SA(0, 1), a2 + hstepA, voffA);
            PG8_WAIT_V(8); PG8_WAIT_L(0); PG8_BAR; PG8_MMA(0, 0, At, B0); PG8_MMA(0, 1, At, B1); PG8_BAR; PG8_SCHED;
            PG8_LDA(At, 1, 1); PG8_STAGE(PG8_SB(1, 0), b3, voffB); PG8_STAGE(PG8_SB(1, 1), b3 + hstepB, voffB); PG8_STAGE(PG8_SA(1, 0), a3, voffA);
            PG8_WAIT_V(8); PG8_WAIT_L(0); PG8_BAR; PG8_MMA(1, 0, At, B0); PG8_MMA(1, 1, At, B1); PG8_BAR; PG8_SCHED;
            } else {
            PG8_LDB(B0, 0, 0); PG8_SCHED; PG8_LDA(At, 0, 0); PG8_STAGE(PG8_SA(1, 1), a1 + hstepA, voffA);
            PG8_WAIT_L(8); PG8_BAR; PG8_WAIT_L(0); PG8_MMA(0, 0, At, B0); PG8_BAR; PG8_SCHED;
            PG8_LDB(B1, 0, 1); PG8_STAGE(PG8_SB(0, 0), b2, voffB);
            PG8_BAR; PG8_WAIT_L(0); PG8_MMA(0, 1, At, B1); PG8_BAR;
            PG8_LDA(At, 0, 1); PG8_STAGE(PG8_SA(0, 0), a2, voffA);
            PG8_BAR; PG8_WAIT_L(0); PG8_MMA(1, 0, At, B0); PG8_BAR; PG8_SCHED;
            PG8_STAGE(PG8_SB(0, 1), b2 + hstepB, voffB);
            PG8_WAIT_V(6); PG8_BAR; PG8_MMA(1, 1, At, B1); PG8_BAR;
            PG8_LDB(B0, 1, 0); PG8_SCHED; PG8_LDA(At, 1, 0); PG8_STAGE(PG8_SA(0, 1), a2 + hstepA, voffA);
            PG8_WAIT_L(8); PG8_BAR; PG8_WAIT_L(0); PG8_MMA(0, 0, At, B0); PG8_BAR; PG8_SCHED;
            PG8_LDB(B1, 1, 1); PG8_STAGE(PG8_SB(1, 0), b3, voffB);
            PG8_BAR; PG8_WAIT_L(0); PG8_MMA(0, 1, At, B1); PG8_BAR;
            PG8_LDA(At, 1, 1); PG8_STAGE(PG8_SA(1, 0), a3, voffA);
            PG8_BAR; PG8_WAIT_L(0); PG8_MMA(1, 0, At, B0); PG8_BAR; PG8_SCHED;
            PG8_STAGE(PG8_SB(1, 1), b3 + hstepB, voffB);
            PG8_WAIT_V(6); PG8_BAR; PG8_MMA(1, 1, At, B1); PG8_BAR;
            }
        }
        if constexpr (ALIGN_EPI) { if (wr == 0) PG8_BAR; }
        if constexpr (!Epi::AFTER_DRAIN) { E(acc, cur, wr, wc, fr, fq); S.done(cur); }
        if (!has_next) break;
#pragma unroll
        for (int a = 0; a < 2; ++a)
#pragma unroll
            for (int b = 0; b < 2; ++b)
#pragma unroll
                for (int m = 0; m < 4; ++m)
#pragma unroll
                    for (int n = 0; n < 2; ++n) acc[a][b][m][n] = (f32x4){0.f, 0.f, 0.f, 0.f};
        cur = nxt; cA = nA; cB = nB; ++ui;
        if constexpr (ALIGN_EPI) { if (wr == 1) PG8_BAR; }
    }
    PG8_WAIT_V(0);
    if constexpr (!ALIGN_EPI) { if (wr == 0) PG8_BAR; }
    PG8_BAR;
    if constexpr (Epi::AFTER_DRAIN) { E.fused(acc, cur, wr, wc, fr, fq, lds, wid, lane); S.done(cur); }
#undef PG8_SA
#undef PG8_SB
#undef PG8_STAGE
#undef PG8_LDA
#undef PG8_LDB
#undef PG8_MMA
#undef PG8_WAIT_V
#undef PG8_WAIT_L
#undef PG8_BAR
#undef PG8_SCHED
}
}

#define SBAR() __builtin_amdgcn_sched_barrier(0)
#include <hip/hip_bf16.h>
#include <cmath>
namespace attn_body {
using bf16=__hip_bfloat16;
using bf16x8=__attribute__((ext_vector_type(8)))short;
using s16x4=__attribute__((ext_vector_type(4)))short;
using f32x16=__attribute__((ext_vector_type(16)))float;
using u32x4=__attribute__((ext_vector_type(4)))unsigned;
constexpr int BATCH=16,NHEAD=8,SEQ=2048,D=64,DM=3584;
constexpr int NW=8,QBLK=32,QB=QBLK*NW,KVBLK=64,NQB=SEQ/QB;
constexpr int ATTN_PITCH=DM, ATTN_UNIT_ROWS=QB;
__device__ __forceinline__ int crow(int r,int hi){return (r&3)+8*(r>>2)+4*hi;}
__device__ __forceinline__ float bf2f_s(short v){return __builtin_bit_cast(float,((unsigned)(unsigned short)v)<<16);}
#define SBAR() __builtin_amdgcn_sched_barrier(0)
__device__ __forceinline__ void cmask(f32x16&p0,f32x16&p1,int jb,int qrel,int hi){
  const float NEG=-INFINITY; int kb=64*jb+4*hi;
  #pragma unroll
  for(int r=0;r<16;++r){int kv=kb+(r&3)+8*(r>>2); if(kv>qrel)p0[r]=NEG; if(kv+32>qrel)p1[r]=NEG;}
}

constexpr int NSLOT=3, SLOTB=8192;
constexpr int LDS_K=0, LDS_V=NSLOT*SLOTB, LDS_WS=2*NSLOT*SLOTB, LDS_OST=LDS_WS+NW*64*4, LDS_BYTES=LDS_OST+NW*4096;
constexpr float C2=0.125f*1.4426950408889634f;
__device__ __forceinline__ void glds16(const void*gsrc,unsigned lds_dst){unsigned keep;
  asm volatile("s_mov_b32 %0, m0\n\ts_mov_b32 m0, %2\n\ts_nop 0\n\tglobal_load_lds_dwordx4 %1, off\n\ts_mov_b32 m0, %0":"=&s"(keep):"v"(gsrc),"s"(lds_dst):"memory");}
__device__ __forceinline__ float max3f(float a,float b,float c){float r;asm("v_max3_f32 %0, %1, %2, %3":"=v"(r):"v"(a),"v"(b),"v"(c));return r;}
__device__ __forceinline__ float max2f(float a,float b){float r;asm("v_max_f32_e32 %0, %1, %2":"=v"(r):"v"(a),"v"(b));return r;}
__device__ __forceinline__ float fadd_s(float a,float b){float r;asm("v_add_f32_e32 %0, %1, %2":"=v"(r):"v"(a),"v"(b));return r;}
__device__ __forceinline__ float fsub_s(float a,float b){float r;asm("v_sub_f32_e32 %0, %1, %2":"=v"(r):"v"(a),"v"(b));return r;}
typedef float f32x2_t __attribute__((ext_vector_type(2))); typedef __bf16 bf16x2_t __attribute__((ext_vector_type(2)));
__device__ __forceinline__ unsigned cvtpk_s(float lo,float hi){f32x2_t v={lo,hi};bf16x2_t b=__builtin_convertvector(v,bf16x2_t);return __builtin_bit_cast(unsigned,b);}
#define WAIT_BAR(N) asm volatile("s_waitcnt vmcnt(" #N ") lgkmcnt(0)\n\ts_barrier":::"memory")

__device__ __forceinline__ void qkt(f32x16&p0,f32x16&p1,const char*Kslot,const bf16x8*qr,const f32x16&negm,int r32,int hi){
  const char*kb=Kslot+hi*1024+r32*16;
  #pragma unroll
  for(int d0=0;d0<4;++d0){
    const bf16x8 b0=*reinterpret_cast<const bf16x8*>(kb+d0*2048);
    const bf16x8 b1=*reinterpret_cast<const bf16x8*>(kb+d0*2048+512);
    if(d0==0){p0=__builtin_amdgcn_mfma_f32_32x32x16_bf16(b0,qr[0],negm,0,0,0);p1=__builtin_amdgcn_mfma_f32_32x32x16_bf16(b1,qr[0],negm,0,0,0);}
    else{p0=__builtin_amdgcn_mfma_f32_32x32x16_bf16(b0,qr[d0],p0,0,0,0);p1=__builtin_amdgcn_mfma_f32_32x32x16_bf16(b1,qr[d0],p1,0,0,0);}}
}
typedef __attribute__((address_space(3))) const char* lds_cptr;
typedef short v4i16_t __attribute__((ext_vector_type(4)));
__device__ __forceinline__ void kload8(bf16x8*kf,lds_cptr kp){
  kf[0]=*(const __attribute__((address_space(3))) bf16x8*)(kp);      kf[1]=*(const __attribute__((address_space(3))) bf16x8*)(kp+512);
  kf[2]=*(const __attribute__((address_space(3))) bf16x8*)(kp+2048); kf[3]=*(const __attribute__((address_space(3))) bf16x8*)(kp+2560);
  kf[4]=*(const __attribute__((address_space(3))) bf16x8*)(kp+4096); kf[5]=*(const __attribute__((address_space(3))) bf16x8*)(kp+4608);
  kf[6]=*(const __attribute__((address_space(3))) bf16x8*)(kp+6144); kf[7]=*(const __attribute__((address_space(3))) bf16x8*)(kp+6656);
}
__device__ __forceinline__ void kload2(bf16x8*kf,lds_cptr kp,int j){ kf[2*j]=*(const __attribute__((address_space(3))) bf16x8*)(kp+j*2048); kf[2*j+1]=*(const __attribute__((address_space(3))) bf16x8*)(kp+j*2048+512); }
__device__ __forceinline__ s16x4 vtr(lds_cptr p){ return __builtin_bit_cast(s16x4,__builtin_amdgcn_ds_read_tr16_b64_v4i16((__attribute__((address_space(3))) v4i16_t*)p)); }
__device__ __forceinline__ float rowmax(const f32x16&p0,const f32x16&p1){
  float a=max3f(p0[0],p0[1],p1[0]),b=max3f(p0[2],p0[3],p1[1]);a=max3f(a,p1[2],p1[3]);
  #pragma unroll
  for(int r=4;r<16;r+=4){a=max3f(a,p0[r],p0[r+1]);b=max3f(b,p0[r+2],p0[r+3]);a=max3f(a,p1[r],p1[r+1]);b=max3f(b,p1[r+2],p1[r+3]);}
  const float m=max2f(a,b);
  auto rr=__builtin_amdgcn_permlane32_swap(__float_as_uint(m),__float_as_uint(m),false,false);
  return max2f(__uint_as_float(rr[0]),__uint_as_float(rr[1]));
}
__device__ __forceinline__ void pv(f32x16*o,int vb,bf16x8 pa0,bf16x8 pa1,bf16x8 pa2,bf16x8 pa3){
  #pragma unroll
  for(int d0=0;d0<2;++d0){s16x4 lo[4],hi[4];
    #pragma unroll
    for(int ks=0;ks<4;++ks){
      asm volatile("ds_read_b64_tr_b16 %0,%1 offset:%c2":"=&v"(lo[ks]):"v"(vb),"i"(d0*4096+ks*1024):"memory");
      asm volatile("ds_read_b64_tr_b16 %0,%1 offset:%c2":"=&v"(hi[ks]):"v"(vb),"i"(d0*4096+ks*1024+512):"memory");}
    asm volatile("s_waitcnt lgkmcnt(0)":::"memory");SBAR();
    #define PK(k) (bf16x8){lo[k][0],lo[k][1],lo[k][2],lo[k][3],hi[k][0],hi[k][1],hi[k][2],hi[k][3]}
    o[d0]=__builtin_amdgcn_mfma_f32_32x32x16_bf16(pa0,PK(0),o[d0],0,0,0);
    o[d0]=__builtin_amdgcn_mfma_f32_32x32x16_bf16(pa1,PK(1),o[d0],0,0,0);
    o[d0]=__builtin_amdgcn_mfma_f32_32x32x16_bf16(pa2,PK(2),o[d0],0,0,0);
    o[d0]=__builtin_amdgcn_mfma_f32_32x32x16_bf16(pa3,PK(3),o[d0],0,0,0);
    #undef PK
  }
}

#ifndef ATTN_STORE16
#define ATTN_STORE16(p,v) (*(u32x4*)(p)=(v))
#endif
template<int THRL> __device__ __forceinline__ void attn_unit(int b,int h,int qb,const bf16*Q,const bf16*__restrict__ K,const bf16*__restrict__ V,bf16*O,const float*kmean,char*shm,const int wid){
  const int lane=lane_id_opaque(),r32=lane&31,hi=lane>>5;
  const long rowbase=(long)b*SEQ; const int q0=qb*QB;
  const bf16*Qw=Q+(rowbase+q0+wid*QBLK)*DM+h*D;
  const bf16*Kh=K+rowbase*DM+h*D,*Vh=V+rowbase*DM+h*D;
  const unsigned lds0=(unsigned)(uintptr_t)shm;
  float*wsf=(float*)(shm+LDS_WS)+wid*64;
  const bf16*ksrc=Kh+(long)lane*DM+wid*8;
  const bf16*vsrc=Vh+(long)(16*(wid&3)+(lane>>2))*DM+(wid>>2)*32+(lane&3)*8;
  const unsigned kdst=lds0+LDS_K+wid*1024, vdst=lds0+LDS_V+wid*1024;
  #define DMA_K(t,slot) glds16(ksrc+(long)(t)*KVBLK*DM,(unsigned)__builtin_amdgcn_readfirstlane(kdst+(slot)))
  #define DMA_V(t,slot) glds16(vsrc+(long)(t)*KVBLK*DM,(unsigned)__builtin_amdgcn_readfirstlane(vdst+(slot)))
  const int vb0=(int)(lds0+LDS_V)+((lane>>4)&1)*32+(lane&3)*8+(4*hi+((lane&15)>>2))*64;
  const char*Kbase=shm+LDS_K; bf16x8 kf[8];
  const lds_cptr shm3=(lds_cptr)shm; const lds_cptr kp0=shm3+LDS_K+hi*1024+r32*16; const lds_cptr vp0=shm3+LDS_V+((lane>>4)&1)*32+(lane&3)*8+(4*hi+((lane&15)>>2))*64;
  const int NT=(q0+QB)/KVBLK;
  DMA_K(0,0);DMA_V(0,0);DMA_K(1,SLOTB);
  bf16x8 qr[4];
  #pragma unroll
  for(int d0=0;d0<4;++d0)qr[d0]=*reinterpret_cast<const bf16x8*>(&Qw[(long)r32*DM+d0*16+hi*8]);
  unsigned selmask=(qb<=3)?((1u<<qb)-1u):0u;
  if(qb>3){ float gate[7];
    #pragma unroll
    for(int j=0;j<7;++j){ gate[j]=-INFINITY;
      if(j<qb){ const float*km=kmean+((long)((b*NHEAD+h)*(SEQ/QB)+j))*D+hi*8; float sg=0.f;
        #pragma unroll
        for(int d0=0;d0<4;++d0){ const float4 k0=*(const float4*)(km+d0*16),k1=*(const float4*)(km+d0*16+4); const bf16x8 qv=qr[d0];
          sg+=bf2f_s(qv[0])*k0.x+bf2f_s(qv[1])*k0.y+bf2f_s(qv[2])*k0.z+bf2f_s(qv[3])*k0.w+bf2f_s(qv[4])*k1.x+bf2f_s(qv[5])*k1.y+bf2f_s(qv[6])*k1.z+bf2f_s(qv[7])*k1.w; }
        sg+=__shfl_xor(sg,32); gate[j]=sg; } }
    #pragma unroll
    for(int rnk=0;rnk<3;++rnk){ int best=0; float bv=-INFINITY;
      #pragma unroll
      for(int j=0;j<7;++j){ const bool ok=(j<qb)&&!((selmask>>j)&1u)&&(gate[j]>bv); if(ok){bv=gate[j];best=j;} }
      selmask|=1u<<best; } }
  ((unsigned*)wsf)[32+r32]=selmask;
  float mhat=0.f,l_reg=0.f;f32x16 o[2];o[0]=f32x16{};o[1]=f32x16{};const f32x16 negm=f32x16{};
  const int qrel=wid*QBLK+r32;
  #define SELM() (((const unsigned*)wsf)[32+r32])
  #define CMASK(P0,P1,t) do{int jb_=(t)-(NT-4); if(jb_>=0)cmask(P0,P1,jb_,qrel,hi); else if(!((SELM()>>((t)>>2))&1u)){ _Pragma("unroll") for(int r_=0;r_<16;++r_){P0[r_]=-INFINITY;P1[r_]=-INFINITY;} } }while(0)
  bool resc=false;
  #define START(P0,P1) do{ const float rm=rowmax(P0,P1); resc=false; \
    { const float dl=(rm>-1e30f)?rm:0.f; mhat=fadd_s(mhat,dl); \
      _Pragma("unroll") for(int r=0;r<16;++r){P0[r]=fsub_s(P0[r],dl);P1[r]=fsub_s(P1[r],dl);} \
      } \
    _Pragma("unroll") for(int r=0;r<16;++r)P0[r]=__builtin_amdgcn_exp2f(P0[r]); }while(0)
  #define RESC() do{ if(resc){ asm volatile("s_waitcnt lgkmcnt(0)":::"memory"); \
      _Pragma("unroll") for(int d_=0;d_<2;++d_) _Pragma("unroll") for(int r=0;r<16;++r)o[d_][r]*=wsf[crow(r,hi)]; } }while(0)
  f32x16 pA0,pA1,pB0,pB1;
  int sl_prev=0,sl_cur=0,sl_next=SLOTB;
  #define ROT() do{sl_prev=sl_cur;sl_cur=sl_next;sl_next=(sl_next==(NSLOT-1)*SLOTB)?0:sl_next+SLOTB;}while(0)
  DMA_K(2,2*SLOTB);
  WAIT_BAR(3);
  qkt(pA0,pA1,Kbase,qr,negm,r32,hi);asm volatile("s_nop 15\n\ts_nop 7":"+v"(pA0),"+v"(pA1));CMASK(pA0,pA1,0);
  START(pA0,pA1);
  _Pragma("unroll") for(int r=0;r<16;++r)pA1[r]=__builtin_amdgcn_exp2f(pA1[r]);
  WAIT_BAR(0);
  DMA_K(3,0);DMA_V(1,SLOTB);
  ROT();
  kload8(kf,kp0+sl_cur);
  WAIT_BAR(2);
  s16x4 vlo[8],vhi[8]; u32x4 pw0,pw1,pw2,pw3;
  #define PKW(P,B) cvtpk_s(P[B],P[B+1])
  #define PAF(k) __builtin_bit_cast(bf16x8,pw##k)
  #define VFR(i) (bf16x8){vlo[i][0],vlo[i][1],vlo[i][2],vlo[i][3],vhi[i][0],vhi[i][1],vhi[i][2],vhi[i][3]}
  #define PIN(x) asm volatile("":"+v"(x))
  #define MX3(a,b,c) __builtin_fmaxf(__builtin_fmaxf((a),(b)),(c))
  #define GAPA(MF,A0,A1,A2,A3,W0,W1,PW) do{ MF; sacc+=A0; sacc+=A1; sacc+=A2; sacc+=A3; PIN(sacc); W0; W1; PIN(PW); SBAR(); }while(0)
  #define EX(v) __builtin_amdgcn_exp2f(v)
  #define EXB(v,HB) EX(v)
  #define GAPB(MF,X,B,HB) do{ MF; X[B]=EXB(X[B],HB); X[B+1]=EXB(X[B+1],HB); X[B+2]=EXB(X[B+2],HB); X[B+3]=EXB(X[B+3],HB); PIN(X); SBAR(); }while(0)
  #define VRD(i) do{ vlo[i]=vtr(vp_+(((i)>>2)*4096+((i)&3)*1024)); vhi[i]=vtr(vp_+(((i)>>2)*4096+((i)&3)*1024+512)); }while(0)
  #define KRD(G,j) do{ if(G){ kload2(kf,kp0+sl_next,j); SBAR(); } }while(0)
  #define STEP(C0,C1,P0,P1,t,GK,GV,GL,HB) do{ SBAR(); \
    const float bias_=(((t)<NT-4)&&!((SELM()>>((t)>>2))&1u))?-INFINITY:0.f; \
    const lds_cptr vp_=vp0+sl_prev; \
    VRD(0); SBAR(); float sacc=(P0[0]+P0[1]); \
    GAPA(C0=__builtin_amdgcn_mfma_f32_32x32x16_bf16(kf[0],qr[0],negm,0,0,0), P0[2],P0[3],P0[4],P0[5],     pw0[0]=PKW(P0,0), pw0[1]=PKW(P0,2), pw0); \
    VRD(4); SBAR(); GAPA(C1=__builtin_amdgcn_mfma_f32_32x32x16_bf16(kf[1],qr[0],negm,0,0,0), P0[6],P0[7],P0[8],P0[9],     pw0[2]=PKW(P0,4), pw0[3]=PKW(P0,6), pw0); \
    VRD(1); SBAR(); GAPA(C0=__builtin_amdgcn_mfma_f32_32x32x16_bf16(kf[2],qr[1],C0,0,0,0),   P0[10],P0[11],P0[12],P0[13], pw1[0]=PKW(P0,8), pw1[1]=PKW(P0,10), pw1); \
    VRD(5); SBAR(); GAPA(C1=__builtin_amdgcn_mfma_f32_32x32x16_bf16(kf[3],qr[1],C1,0,0,0),   P0[14],P0[15],P1[0],P1[1],   pw1[2]=PKW(P0,12),pw1[3]=PKW(P0,14), pw1); \
    VRD(2); SBAR(); GAPA(C0=__builtin_amdgcn_mfma_f32_32x32x16_bf16(kf[4],qr[2],C0,0,0,0),   P1[2],P1[3],P1[4],P1[5],     pw2[0]=PKW(P1,0), pw2[1]=PKW(P1,2), pw2); \
    VRD(6); SBAR(); GAPA(C1=__builtin_amdgcn_mfma_f32_32x32x16_bf16(kf[5],qr[2],C1,0,0,0),   P1[6],P1[7],P1[8],P1[9],     pw2[2]=PKW(P1,4), pw2[3]=PKW(P1,6), pw2); \
    VRD(3); SBAR(); GAPA(C0=__builtin_amdgcn_mfma_f32_32x32x16_bf16(kf[6],qr[3],C0,0,0,0),   P1[10],P1[11],P1[12],P1[13], pw3[0]=PKW(P1,8), pw3[1]=PKW(P1,10), pw3); \
    VRD(7); SBAR(); GAPA(C1=__builtin_amdgcn_mfma_f32_32x32x16_bf16(kf[7],qr[3],C1,0,0,0),   P1[14],P1[15],0.f,0.f,       pw3[2]=PKW(P1,12),pw3[3]=PKW(P1,14), pw3); \
    l_reg+=sacc; \
    if(GK){DMA_K((t)+3,sl_cur);} if(GV){DMA_V((t)+1,sl_next);} \
    CMASK(C0,C1,t); \
    { const float mb_=mhat-bias_; _Pragma("unroll") for(int r=0;r<16;++r){C0[r]-=mb_;C1[r]-=mb_;} } \
    { float a=MX3(C0[0],C0[1],C1[0]),b=MX3(C0[2],C0[3],C1[1]); a=MX3(a,C1[2],C1[3]); \
      _Pragma("unroll") for(int r=4;r<16;r+=4){a=MX3(a,C0[r],C0[r+1]);b=MX3(b,C0[r+2],C0[r+3]);a=MX3(a,C1[r],C1[r+1]);b=MX3(b,C1[r+2],C1[r+3]);} \
      float rm=__builtin_fmaxf(a,b); { auto rr=__builtin_amdgcn_permlane32_swap(__float_as_uint(rm),__float_as_uint(rm),false,false); rm=__builtin_fmaxf(__uint_as_float(rr[0]),__uint_as_float(rr[1])); } \
      resc=false; \
      if(__builtin_expect(__any(rm>(float)THRL),0)){ const float dl=__builtin_fmaxf(rm,0.f); mhat+=dl; \
        _Pragma("unroll") for(int r=0;r<16;++r){C0[r]-=dl;C1[r]-=dl;} \
        const float f=__builtin_amdgcn_exp2f(-dl); l_reg*=f; if(hi==0)wsf[r32]=f; resc=true; } } \
    SBAR(); \
    GAPB(o[0]=__builtin_amdgcn_mfma_f32_32x32x16_bf16(PAF(0),VFR(0),o[0],0,0,0), C0,0,HB); \
    GAPB(o[1]=__builtin_amdgcn_mfma_f32_32x32x16_bf16(PAF(0),VFR(4),o[1],0,0,0), C0,4,HB); \
    KRD(GL,0); GAPB(o[0]=__builtin_amdgcn_mfma_f32_32x32x16_bf16(PAF(1),VFR(1),o[0],0,0,0), C0,8,HB); \
    KRD(GL,1); GAPB(o[1]=__builtin_amdgcn_mfma_f32_32x32x16_bf16(PAF(1),VFR(5),o[1],0,0,0), C0,12,HB); \
    KRD(GL,2); GAPB(o[0]=__builtin_amdgcn_mfma_f32_32x32x16_bf16(PAF(2),VFR(2),o[0],0,0,0), C1,0,HB); \
    KRD(GL,3); GAPB(o[1]=__builtin_amdgcn_mfma_f32_32x32x16_bf16(PAF(2),VFR(6),o[1],0,0,0), C1,4,HB); \
    GAPB(o[0]=__builtin_amdgcn_mfma_f32_32x32x16_bf16(PAF(3),VFR(3),o[0],0,0,0), C1,8,HB); \
    GAPB(o[1]=__builtin_amdgcn_mfma_f32_32x32x16_bf16(PAF(3),VFR(7),o[1],0,0,0), C1,12,HB); \
    }while(0)
  int t=1;
  #undef CMASK
  #define CMASK(P0,P1,t) do{}while(0)
  for(;t+5<NT;t+=2){
    STEP(pB0,pB1,pA0,pA1,t,true,true,true,1);     WAIT_BAR(2); RESC(); ROT();
    STEP(pA0,pA1,pB0,pB1,t+1,true,true,true,1);   WAIT_BAR(2); RESC(); ROT();
  }
  #undef CMASK
  #define CMASK(P0,P1,t) do{int jb_=(t)-(NT-4); if(jb_>=0)cmask(P0,P1,jb_,qrel,hi);}while(0)
  #define ENDW(tt) do{ if((tt)+3<NT){WAIT_BAR(2);} else if((tt)+2<NT){WAIT_BAR(1);} else {WAIT_BAR(0);} }while(0)
  for(;t+1<NT;t+=2){
    STEP(pB0,pB1,pA0,pA1,t,(t+3<NT),(t+1<NT),(t+1<NT),1);       ENDW(t);   RESC(); ROT();
    STEP(pA0,pA1,pB0,pB1,t+1,(t+4<NT),(t+2<NT),(t+2<NT),1);     ENDW(t+1); RESC(); ROT();
  }
  STEP(pB0,pB1,pA0,pA1,NT-1,false,false,false,1); RESC();
  { float sacc=pB0[0]+pB0[1]; _Pragma("unroll") for(int r=2;r<16;++r)sacc+=pB0[r]; _Pragma("unroll") for(int r=0;r<16;++r)sacc+=pB1[r]; l_reg+=sacc;
    pw0=(u32x4){PKW(pB0,0),PKW(pB0,2),PKW(pB0,4),PKW(pB0,6)};pw1=(u32x4){PKW(pB0,8),PKW(pB0,10),PKW(pB0,12),PKW(pB0,14)};pw2=(u32x4){PKW(pB1,0),PKW(pB1,2),PKW(pB1,4),PKW(pB1,6)};pw3=(u32x4){PKW(pB1,8),PKW(pB1,10),PKW(pB1,12),PKW(pB1,14)};
    SBAR(); pv(o,vb0+sl_cur,PAF(0),PAF(1),PAF(2),PAF(3)); }
  #undef PKW
  #undef PAF
  #undef VFR
  #undef PIN
  #undef MX3
  #undef GAPA
  #undef GAPB
  #undef EX
  #undef EXB
  #undef VRD
  #undef KRD
  #undef STEP
  #undef ENDW
  {auto rr=__builtin_amdgcn_permlane32_swap(__float_as_uint(l_reg),__float_as_uint(l_reg),false,false);l_reg=__uint_as_float(rr[0])+__uint_as_float(rr[1]);}
  if(hi==0)wsf[32+r32]=l_reg;asm volatile("s_waitcnt lgkmcnt(0)":::"memory");
  float rli[16];
  #pragma unroll
  for(int r=0;r<16;++r)rli[r]=__builtin_amdgcn_rcpf(wsf[32+crow(r,hi)]);
  bf16*Ow=O+(rowbase+q0+wid*QBLK)*DM+h*D;
  { bf16*stg=(bf16*)(shm+LDS_OST)+wid*2048;
    #pragma unroll
    for(int r=0;r<16;++r){const int orow=crow(r,hi);
      #pragma unroll
      for(int d0=0;d0<2;++d0)stg[orow*64+d0*32+r32]=__float2bfloat16(o[d0][r]*rli[r]);}
    asm volatile("s_waitcnt lgkmcnt(0)":::"memory");
    #pragma unroll
    for(int i=0;i<4;++i){const int row=i*8+(lane>>3),ch=lane&7; const u32x4 v=*(const u32x4*)(stg+row*64+ch*8); ATTN_STORE16(Ow+(long)row*DM+ch*8,v);} }
  asm volatile("s_waitcnt lgkmcnt(0)\n\ts_barrier":::"memory");
  #undef DMA_K
  #undef DMA_V
  #undef CMASK
  #undef START
  #undef RESC
  #undef ROT
}
constexpr int ATTN_LDS_BYTES=LDS_BYTES;
struct AttnTensors { const bf16* Q; const bf16* K; const bf16* V; bf16* O; const float* kmean; };
struct AttnUnit { int bh; int qb; };
struct StaticOrder {
  int vcu, G;
  __device__ __forceinline__ explicit StaticOrder(int grid,int block):vcu((grid%8==0)?((block%8)*(grid/8)+block/8):block),G(grid){}
  __device__ __forceinline__ bool next(int i,AttnUnit&u)const{ const int L=(i>>2)*G+vcu; if(L>=BATCH*NHEAD*2)return false; const int s=L&1,k=i&3; u.bh=L>>1; u.qb=(k==0)?s:(k==1)?7-s:(k==2)?2+s:5-s; return true; }
  __device__ __forceinline__ void a_ready(const AttnUnit&)const{}
  __device__ __forceinline__ void done(const AttnUnit&)const{}
};
template<class Sched,int THRL=8> __device__ __forceinline__ void attn_phase(char*lds,const AttnTensors&T,const Sched&S,const int wid){
  AttnUnit u;
  for(int i=0;S.next(i,u);++i){ S.a_ready(u); attn_unit<THRL>(u.bh/NHEAD,u.bh%NHEAD,u.qb,T.Q,T.K,T.V,T.O,T.kmean,lds,wid); S.done(u); }
}
#undef SBAR
#undef WAIT_BAR
}

#define GAS __attribute__((address_space(1)))
#define LAS __attribute__((address_space(3)))
typedef unsigned short bf16;
typedef unsigned v4u __attribute__((ext_vector_type(4)));
typedef float f32x4 __attribute__((ext_vector_type(4)));

constexpr int NWAVES = 8, NTHREADS = NWAVES * 64;
constexpr int NB = 16, NS = 2048, T = NB * NS, D = 1024;
constexpr int NP = 3584;
constexpr int PC_MQ = 0, PC_GZ = 512, PC_MK = 1024, PC_MV = 1536, PC_GQ = 2048, PC_GK = 2560, PC_GV = 3072;
constexpr int WIN_LD = 3592;
constexpr int MH = 8, MD = 64, MBLK = 256, MNB = NS / MBLK;
constexpr int GH = 4, GD = 128;
constexpr int NE = 32, FF = 256;
constexpr int MAXTILES = 288, MAXROWS = MAXTILES * 256;
constexpr float RMS_EPS = 1e-6f;

constexpr size_t MiB = 1u << 20;
constexpr size_t WS_CTL = 0, CTL_ZERO_BYTES = 1 * MiB;
constexpr size_t WS_WIN = 1 * MiB, WS_WOUT = 8 * MiB, WS_WGU = 10 * MiB, WS_WD = 42 * MiB;
constexpr size_t WS_GAB = 58 * MiB, WS_KMEAN = 59 * MiB;
constexpr size_t WS_TOKE = 60 * MiB, WS_TOKW = WS_TOKE + 256 * 1024, WS_TOKR = WS_TOKW + 256 * 1024, WS_ROWMAP = WS_TOKR + 256 * 1024, WS_ROWW = WS_ROWMAP + 512 * 1024, WS_TILEE = WS_ROWW + 512 * 1024;
constexpr size_t WS_HB = 64 * MiB;
constexpr size_t WS_P = 128 * MiB;
constexpr size_t WS_XS = WS_P;
constexpr size_t WS_HID = WS_P + 144 * MiB;
constexpr size_t WS_Y2 = 352 * MiB;
constexpr size_t WS_END = 481 * MiB;
static_assert(WS_TILEE + 4096 <= WS_HB && WS_HID + (size_t)MAXROWS * 256 * 2 <= WS_Y2 && WS_P + (size_t)T * NP * 2 <= WS_Y2, "ws map");
constexpr int CW_CNT = 64;
constexpr int CW_NT = 128;
constexpr int CW_BAR = 4096;

constexpr int LDS_BYTES = 155648;
constexpr int LDS_CTL_OFF = LDS_BYTES - 256;

__device__ __forceinline__ unsigned f2bf(float f) { unsigned u = __builtin_bit_cast(unsigned, f); return (u + 0x7fffu + ((u >> 16) & 1u)) >> 16; }
__device__ __forceinline__ unsigned pk2(float lo, float hi) { return f2bf(lo) | (f2bf(hi) << 16); }
__device__ __forceinline__ float bflo(unsigned u) { return __builtin_bit_cast(float, u << 16); }
__device__ __forceinline__ float bfhi(unsigned u) { return __builtin_bit_cast(float, u & 0xffff0000u); }
__device__ __forceinline__ float bf2f(bf16 h) { return __builtin_bit_cast(float, (unsigned)h << 16); }
__device__ __forceinline__ float wave_sum(float v) {
#pragma unroll
    for (int o = 1; o < 64; o <<= 1) v += __shfl_xor(v, o);
    return v;
}
__device__ __forceinline__ float siluf(float x) { return x / (1.f + __expf(-x)); }

struct Args {
    const float* x; const float* attn_norm; const float* w_in; const float* conv_w; const float* A_log; const float* dt_bias; const float* gdn_norm; const float* w_out;
    const float* ffn_norm; const float* w_group; const float* w_router; const float* w_gate; const float* w_up; const float* w_down; const float* final_norm;
    float* out; unsigned char* ws; int ph_lo, ph_hi;
};

typedef const __attribute__((address_space(4))) Args* KArgs;
struct Ctx {
    LAS unsigned char* lds; int wave, G, bid;
};
__device__ __forceinline__ int lane_id() { return lane_id_opaque(); }
#define LANE_TID const int lane = lane_id(), tid = F.wave * 64 + lane; (void)tid; (void)lane


#define XB_TMO      128
#define XB_XCNT(j)  (256  + 64 * (j))
#define XB_XSUB(j)  (1280 + 64 * (j))
#define XB_XGEN(j)  (2304 + 64 * (j))
#define XB_TOP      3328
#define XB_TOPGEN   3392
#define XCD_BAR_WORDS 3456
#define XB_SPIN_CAP (1u << 20)
__device__ __forceinline__ unsigned xb_ld(unsigned* p)              { return __hip_atomic_load(p, __ATOMIC_RELAXED, __HIP_MEMORY_SCOPE_AGENT); }
__device__ __forceinline__ unsigned xb_add(unsigned* p, unsigned v) { return __hip_atomic_fetch_add(p, v, __ATOMIC_RELAXED, __HIP_MEMORY_SCOPE_AGENT); }
__device__ __forceinline__ unsigned xb_xcc_id() { return (unsigned)__builtin_amdgcn_s_getreg((3 << 11) | 20) & 0xFu; }
#define XB_SPIN(cond, bar) do { unsigned _sp = 0; while (cond) { __builtin_amdgcn_s_sleep(1); \
    if ((++_sp & 255u) == 0u) { if (xb_ld(&(bar)[XB_TMO])) break; if (_sp > XB_SPIN_CAP) { atomicAdd(&(bar)[XB_TMO], 1u); break; } } } } while (0)
struct XcdBarrier { unsigned* bar; unsigned x; volatile LAS unsigned* st; };
__device__ __forceinline__ XcdBarrier xcd_barrier_post(unsigned* bar, volatile LAS unsigned* st, bool leader) {
    XcdBarrier b; b.bar = bar; b.x = xb_xcc_id(); b.st = st;
    if (leader) (void)xb_add(&bar[XB_XCNT(b.x)], 1u);
    return b;
}
__device__ __forceinline__ void xcd_barrier_complete(unsigned* bar, unsigned x, unsigned G, unsigned& nloc, unsigned& nx) {
    unsigned sum, cnt, mine, sp = 0u;
    for (;;) {
        sum = 0u; cnt = 0u; mine = 0u;
#pragma unroll
        for (unsigned j = 0; j < 16; ++j) { const unsigned c = xb_ld(&bar[XB_XCNT(j)]); sum += c; cnt += (c > 0u) ? 1u : 0u; mine = (j == x) ? c : mine; }
        if (sum == G) break;
        __builtin_amdgcn_s_sleep(1);
        if ((++sp & 255u) == 0u) { if (xb_ld(&bar[XB_TMO])) break; if (sp > XB_SPIN_CAP) { atomicAdd(&bar[XB_TMO], 1u); break; } }
    }
    nloc = mine > 0u ? mine : 1u; nx = cnt > 0u ? cnt : 1u;
}
__device__ __forceinline__ void xcd_barrier(const XcdBarrier& b, bool leader, unsigned G) {
    asm volatile("s_waitcnt vmcnt(0)" ::: "memory");
    __syncthreads();
    if (leader) {
        unsigned* bar = b.bar;
        __builtin_amdgcn_s_waitcnt(0);
        unsigned nloc = b.st[0], nx = b.st[1];
        if (nloc == 0u) { xcd_barrier_complete(bar, b.x, G, nloc, nx); b.st[0] = nloc; b.st[1] = nx; }
        const unsigned old = xb_add(&bar[XB_XSUB(b.x)], 1u);
        const unsigned gen = old / nloc;
        if (old + 1u == (gen + 1u) * nloc) {
            __builtin_amdgcn_fence(__ATOMIC_RELEASE, "agent");
            asm volatile("s_waitcnt vmcnt(0)" ::: "memory");
            const unsigned og = xb_add(&bar[XB_TOP], 1u);
            const unsigned tg = og / nx;
            if (og + 1u == (tg + 1u) * nx) xb_add(&bar[XB_TOPGEN], 1u);
            else XB_SPIN(xb_ld(&bar[XB_TOPGEN]) == tg, bar);
            __builtin_amdgcn_fence(__ATOMIC_ACQUIRE, "agent");
            xb_add(&bar[XB_XGEN(b.x)], 1u);
            asm volatile("s_waitcnt vmcnt(0)" ::: "memory");
        } else {
            XB_SPIN(xb_ld(&bar[XB_XGEN(b.x)]) == gen, bar);
            __builtin_amdgcn_fence(__ATOMIC_ACQUIRE, "agent");
            asm volatile("s_waitcnt vmcnt(0)" ::: "memory");
        }
    }
    __syncthreads();
}

__device__ __forceinline__ void tr_item(const float* W, int ldn, int ncol0, int K, int nblk, bf16* WT, int row_off, int rmul, LAS float* scr, int item, int lane) {
    const int kb = item / nblk, nb = item - kb * nblk, k0 = 64 * kb, n0 = 32 * nb;
#pragma unroll 8
    for (int i = 0; i < 32; ++i) { const int kk = 2 * i + (lane >> 5); scr[kk * 33 + (lane & 31)] = W[(size_t)(k0 + kk) * ldn + ncol0 + n0 + (lane & 31)]; }
    asm volatile("s_waitcnt lgkmcnt(0)" ::: "memory");
    const int c = lane & 7;
#pragma unroll
    for (int j = 0; j < 4; ++j) { const int n = (lane >> 3) + 8 * j; const LAS float* s = scr + (8 * c) * 33 + n;
        v4u o; o.x = pk2(s[0 * 33], s[1 * 33]); o.y = pk2(s[2 * 33], s[3 * 33]); o.z = pk2(s[4 * 33], s[5 * 33]); o.w = pk2(s[6 * 33], s[7 * 33]);
        *(v4u*)(WT + (size_t)(row_off + rmul * (n0 + n)) * K + k0 + 8 * c) = o; }
    asm volatile("s_waitcnt lgkmcnt(0)" ::: "memory");
}

__device__ __forceinline__ void p0_prologue(KArgs a, const Ctx& F) {
    LANE_TID;
    unsigned char* ws = a->ws;
    bf16* Win_t = (bf16*)(ws + WS_WIN); bf16* Wout_t = (bf16*)(ws + WS_WOUT); bf16* Wgu_t = (bf16*)(ws + WS_WGU); bf16* Wd_t = (bf16*)(ws + WS_WD);
    LAS float* scr = (LAS float*)(F.lds + F.wave * 8704);
    const int gw = F.bid * NWAVES + F.wave, NGW = F.G * NWAVES;
    constexpr int I_S = 16 * 16;
    constexpr int I_IN = 16 * 112, I_OUT = 16 * 32, I_G = 16 * 8, I_D = 4 * 32;
    constexpr int NITEMS = I_IN + I_OUT + NE * I_G * 2 + NE * I_D;
    for (int it = gw; it < NITEMS; it += NGW) {
        int r = it;
        if (r < I_IN) {
            if (r < I_S)      { tr_item(a->w_in, WIN_LD, 0,    1024, 16, Win_t, PC_MQ, 1, scr, r, lane); continue; } r -= I_S;
            if (r < I_S)      { tr_item(a->w_in, WIN_LD, 3072, 1024, 16, Win_t, PC_GZ, 1, scr, r, lane); continue; } r -= I_S;
            if (r < I_S)      { tr_item(a->w_in, WIN_LD, 512,  1024, 16, Win_t, PC_MK, 1, scr, r, lane); continue; } r -= I_S;
            if (r < I_S)      { tr_item(a->w_in, WIN_LD, 1024, 1024, 16, Win_t, PC_MV, 1, scr, r, lane); continue; } r -= I_S;
            tr_item(a->w_in, WIN_LD, 1536, 1024, 48, Win_t, PC_GQ, 1, scr, r, lane); continue;
        }
        r -= I_IN;
        if (r < I_OUT) { tr_item(a->w_out, 1024, 0, 1024, 32, Wout_t, 0, 1, scr, r, lane); continue; }
        r -= I_OUT;
        if (r < NE * I_G * 2) { const int e = r / (2 * I_G), q = r - e * 2 * I_G, s = q / I_G, ii = q - s * I_G;
            tr_item((s ? a->w_up : a->w_gate) + (size_t)e * 1024 * 256, 256, 0, 1024, 8, Wgu_t, e * 512 + s, 2, scr, ii, lane); continue; }
        r -= NE * I_G * 2;
        { const int e = r / I_D, ii = r - e * I_D; tr_item(a->w_down + (size_t)e * 256 * 1024, 1024, 0, 256, 32, Wd_t, e * 1024, 1, scr, ii, lane); }
    }
    LAS float* W8t = (LAS float*)(F.lds + 73728);
    for (int idx = tid; idx < 8192; idx += NTHREADS) { const int k = idx >> 3, o = idx & 7; W8t[o * 1024 + k] = a->attn_norm[k] * a->w_in[(size_t)k * WIN_LD + 3584 + o]; }
    __syncthreads();
    bf16* hb = (bf16*)(ws + WS_HB); float* gab = (float*)(ws + WS_GAB);
    f32x4 gn[4];
#pragma unroll
    for (int j = 0; j < 4; ++j) gn[j] = ((const f32x4*)a->attn_norm)[64 * j + lane];
    for (int m = gw; m < T; m += NGW) {
        const f32x4* xr = (const f32x4*)(a->x + (size_t)m * D) + lane;
        f32x4 v[4]; float s = 0.f;
#pragma unroll
        for (int j = 0; j < 4; ++j) { v[j] = xr[64 * j]; s += (v[j].x * v[j].x + v[j].y * v[j].y) + (v[j].z * v[j].z + v[j].w * v[j].w); }
        const float rs = 1.0f / sqrtf(wave_sum(s) * (1.f / D) + RMS_EPS);
        uint2* o8 = (uint2*)(hb + (size_t)m * D) + lane;
#pragma unroll
        for (int j = 0; j < 4; ++j) { uint2 o; o.x = pk2(v[j].x * rs * gn[j].x, v[j].y * rs * gn[j].y); o.y = pk2(v[j].z * rs * gn[j].z, v[j].w * rs * gn[j].w); o8[64 * j] = o; }
        float myv = 0.f;
#pragma unroll
        for (int o = 0; o < 8; ++o) { float acc = 0.f;
#pragma unroll
            for (int j = 0; j < 4; ++j) { const f32x4 w = *(const LAS f32x4*)(W8t + o * 1024 + 256 * j + 4 * lane); acc += (v[j].x * w.x + v[j].y * w.y) + (v[j].z * w.z + v[j].w * w.w); }
            acc = wave_sum(acc) * rs; if (lane == o) myv = acc; }
        if (lane < 8) gab[(size_t)m * 8 + lane] = myv;
    }
}

__device__ __forceinline__ void p2_kmean(KArgs a, const Ctx& F) {
    LANE_TID;
    const bf16* P = (const bf16*)(a->ws + WS_P); float* kmean = (float*)(a->ws + WS_KMEAN);
    const int gw = F.bid * NWAVES + F.wave, NGW = F.G * NWAVES;
    for (int it = gw; it < NB * MH * MNB; it += NGW) {
        const int blk = it % MNB, h = (it / MNB) % MH, b = it / (MNB * MH);
        const bf16* kp = P + (size_t)(b * NS + blk * MBLK) * NP + PC_MK + h * MD + lane;
        float s = 0.f;
#pragma unroll 8
        for (int r = 0; r < MBLK; ++r) s += bf2f(kp[(size_t)r * NP]);
        kmean[(size_t)it * MD + lane] = s * (1.f / MBLK);
    }
}

__device__ __forceinline__ void p3_attn_naive(KArgs a, const Ctx& F) {
    LANE_TID;
    bf16* P = (bf16*)(a->ws + WS_P); const float* kmean = (const float*)(a->ws + WS_KMEAN);
    const int gw = F.bid * NWAVES + F.wave, NGW = F.G * NWAVES;
    for (int u = gw; u < NB * MH * (NS / 64); u += NGW) {
        const int qt = u % (NS / 64), h = (u / (NS / 64)) % MH, b = u / ((NS / 64) * MH);
        const int own = qt >> 2, t = qt * 64 + lane;
        const size_t rowbase = (size_t)b * NS;
        bf16* qp = P + (rowbase + t) * NP + PC_MQ + h * MD;
        unsigned qk[32];
#pragma unroll
        for (int i = 0; i < 8; ++i) { const v4u w = ((const v4u*)qp)[i]; qk[4 * i] = w.x; qk[4 * i + 1] = w.y; qk[4 * i + 2] = w.z; qk[4 * i + 3] = w.w; }
        float gate[7];
#pragma unroll
        for (int j = 0; j < 7; ++j) { gate[j] = -INFINITY;
            if (j < own) { const float* km = kmean + ((size_t)((b * MH + h) * MNB + j)) * MD; float s = 0.f;
#pragma unroll
                for (int d = 0; d < 32; ++d) s += bflo(qk[d]) * km[2 * d] + bfhi(qk[d]) * km[2 * d + 1];
                gate[j] = s; } }
        unsigned mask = 0u;
        if (own <= 3) mask = (1u << own) - 1u;
        else {
#pragma unroll
            for (int r = 0; r < 3; ++r) { int best = 0; float bv = -INFINITY;
#pragma unroll
                for (int j = 0; j < 7; ++j) { const bool ok = (j < own) && !((mask >> j) & 1u) && (gate[j] > bv); if (ok) { bv = gate[j]; best = j; } }
                mask |= 1u << best; }
        }
        float o[64];
#pragma unroll
        for (int d = 0; d < 64; ++d) o[d] = 0.f;
        float mrun = -1e30f, lrun = 0.f;
        const bf16* Kb = P + rowbase * NP + PC_MK + h * MD; const bf16* Vb = P + rowbase * NP + PC_MV + h * MD;
        for (int j = 0; j <= own; ++j) {
            const bool isown = (j == own);
            const bool sel = isown || ((mask >> j) & 1u);
            if (__ballot(sel) == 0ull) continue;
            const int nk = isown ? ((qt & 3) * 64 + 64) : MBLK;
#pragma unroll 1
            for (int kk = 0; kk < nk; ++kk) {
                const int key = j * MBLK + kk; const v4u* kp = (const v4u*)(Kb + (size_t)key * NP); float acc = 0.f;
#pragma unroll
                for (int c = 0; c < 8; ++c) { const v4u w = kp[c];
                    acc += bflo(qk[4 * c]) * bflo(w.x) + bfhi(qk[4 * c]) * bfhi(w.x) + bflo(qk[4 * c + 1]) * bflo(w.y) + bfhi(qk[4 * c + 1]) * bfhi(w.y)
                         + bflo(qk[4 * c + 2]) * bflo(w.z) + bfhi(qk[4 * c + 2]) * bfhi(w.z) + bflo(qk[4 * c + 3]) * bflo(w.w) + bfhi(qk[4 * c + 3]) * bfhi(w.w); }
                const bool valid = sel && (!isown || key <= t);
                const float sc = valid ? acc * 0.125f : -1e30f;
                const float mnew = fmaxf(mrun, sc), alpha = __expf(mrun - mnew);
                const float p = valid ? __expf(sc - mnew) : 0.f;
                lrun = lrun * alpha + p; mrun = mnew;
                const v4u* vp = (const v4u*)(Vb + (size_t)key * NP);
#pragma unroll
                for (int c = 0; c < 8; ++c) { const v4u w = vp[c];
                    o[8 * c + 0] = o[8 * c + 0] * alpha + p * bflo(w.x); o[8 * c + 1] = o[8 * c + 1] * alpha + p * bfhi(w.x); o[8 * c + 2] = o[8 * c + 2] * alpha + p * bflo(w.y); o[8 * c + 3] = o[8 * c + 3] * alpha + p * bfhi(w.y);
                    o[8 * c + 4] = o[8 * c + 4] * alpha + p * bflo(w.z); o[8 * c + 5] = o[8 * c + 5] * alpha + p * bfhi(w.z); o[8 * c + 6] = o[8 * c + 6] * alpha + p * bflo(w.w); o[8 * c + 7] = o[8 * c + 7] * alpha + p * bfhi(w.w); }
            }
        }
        const float inv = 1.f / lrun;
#pragma unroll
        for (int i = 0; i < 8; ++i) { v4u w; w.x = pk2(o[8 * i] * inv, o[8 * i + 1] * inv); w.y = pk2(o[8 * i + 2] * inv, o[8 * i + 3] * inv); w.z = pk2(o[8 * i + 4] * inv, o[8 * i + 5] * inv); w.w = pk2(o[8 * i + 6] * inv, o[8 * i + 7] * inv);
            ((v4u*)qp)[i] = w; }
    }
}

__device__ __forceinline__ void p3_gdn_naive(KArgs a, const Ctx& F) {
    LANE_TID;
    bf16* P = (bf16*)(a->ws + WS_P); const float* gab = (const float*)(a->ws + WS_GAB);
    LAS float* red = (LAS float*)(F.lds);
    LAS float* red2 = red + 16;
    LAS float* qs = red + 32;
    LAS float* ks = qs + 512;
    const int h = tid >> 7, c = tid & 127, wv = (tid >> 6) & 1;
    for (int b = F.bid; b < NB; b += F.G) {
        float S[128];
#pragma unroll
        for (int k = 0; k < 128; ++k) S[k] = 0.f;
        float xq0 = 0.f, xq1 = 0.f, xq2 = 0.f, xk0 = 0.f, xk1 = 0.f, xk2 = 0.f, xv0 = 0.f, xv1 = 0.f, xv2 = 0.f;
        float cq[4], ck[4], cv[4];
#pragma unroll
        for (int i = 0; i < 4; ++i) { cq[i] = a->conv_w[i * 1536 + h * 128 + c]; ck[i] = a->conv_w[i * 1536 + 512 + h * 128 + c]; cv[i] = a->conv_w[i * 1536 + 1024 + h * 128 + c]; }
        const float negA = -__expf(a->A_log[h]), dtb = a->dt_bias[h], gnorm = a->gdn_norm[c];
        for (int t = 0; t < NS; ++t) {
            const size_t row = (size_t)b * NS + t;
            bf16* pr = P + row * NP;
            const float xq3 = bf2f(pr[PC_GQ + h * 128 + c]), xk3 = bf2f(pr[PC_GK + h * 128 + c]), xv3 = bf2f(pr[PC_GV + h * 128 + c]);
            const float gz = bf2f(pr[PC_GZ + h * 128 + c]);
            const float ga = gab[row * 8 + h], gb = gab[row * 8 + 4 + h];
            const float qv = siluf(cq[0] * xq0 + cq[1] * xq1 + cq[2] * xq2 + cq[3] * xq3);
            const float kv = siluf(ck[0] * xk0 + ck[1] * xk1 + ck[2] * xk2 + ck[3] * xk3);
            const float vv = siluf(cv[0] * xv0 + cv[1] * xv1 + cv[2] * xv2 + cv[3] * xv3);
            xq0 = xq1; xq1 = xq2; xq2 = xq3; xk0 = xk1; xk1 = xk2; xk2 = xk3; xv0 = xv1; xv1 = xv2; xv2 = xv3;
            const float sq = wave_sum(qv * qv), sk = wave_sum(kv * kv);
            if (lane == 0) { red[(h * 2 + wv) * 2 + 0] = sq; red[(h * 2 + wv) * 2 + 1] = sk; }
            __syncthreads();
            const float ssq = red[(h * 2 + 0) * 2 + 0] + red[(h * 2 + 1) * 2 + 0], ssk = red[(h * 2 + 0) * 2 + 1] + red[(h * 2 + 1) * 2 + 1];
            const float nq = (1.0f / sqrtf(ssq + 1e-6f)) * 0.08838834764831845f, nk = 1.0f / sqrtf(ssk + 1e-6f);
            qs[h * 128 + c] = qv * nq; ks[h * 128 + c] = kv * nk;
            __syncthreads();
            const float xsp = ga + dtb; const float sp = xsp > 20.f ? xsp : log1pf(__expf(xsp));
            const float g = negA * sp, ea = __expf(g), beta = 1.f / (1.f + __expf(-gb));
            float kTS = 0.f;
#pragma unroll
            for (int k4 = 0; k4 < 32; ++k4) { const f32x4 kk = *(const LAS f32x4*)(ks + h * 128 + 4 * k4);
                kTS += kk.x * S[4 * k4] + kk.y * S[4 * k4 + 1] + kk.z * S[4 * k4 + 2] + kk.w * S[4 * k4 + 3];
                if ((k4 & 3) == 3) asm volatile("" ::: "memory"); }
            const float uu = beta * (vv - ea * kTS);
            float ov = 0.f;
#pragma unroll
            for (int k4 = 0; k4 < 32; ++k4) { const f32x4 kk = *(const LAS f32x4*)(ks + h * 128 + 4 * k4); const f32x4 qq = *(const LAS f32x4*)(qs + h * 128 + 4 * k4);
                S[4 * k4] = ea * S[4 * k4] + kk.x * uu; ov += qq.x * S[4 * k4];
                S[4 * k4 + 1] = ea * S[4 * k4 + 1] + kk.y * uu; ov += qq.y * S[4 * k4 + 1];
                S[4 * k4 + 2] = ea * S[4 * k4 + 2] + kk.z * uu; ov += qq.z * S[4 * k4 + 2];
                S[4 * k4 + 3] = ea * S[4 * k4 + 3] + kk.w * uu; ov += qq.w * S[4 * k4 + 3];
                if ((k4 & 3) == 3) asm volatile("" ::: "memory"); }
            const float so = wave_sum(ov * ov);
            if (lane == 0) red2[h * 2 + wv] = so;
            __syncthreads();
            const float rso = 1.0f / sqrtf((red2[h * 2] + red2[h * 2 + 1]) * (1.f / 128.f) + RMS_EPS);
            const float y = ov * rso * gnorm * siluf(gz);
            pr[PC_GZ + h * 128 + c] = (bf16)f2bf(y);
        }
        __syncthreads();
    }
}

__device__ __forceinline__ void p5_router(KArgs a, const Ctx& F) {
    LANE_TID;
    unsigned char* ws = a->ws;
    const float* x1 = a->out; bf16* hb = (bf16*)(ws + WS_HB);
    int* tok_e = (int*)(ws + WS_TOKE); float* tok_w = (float*)(ws + WS_TOKW); int* tok_r = (int*)(ws + WS_TOKR);
    unsigned* gcnt = (unsigned*)(ws + WS_CTL) + CW_CNT;
    LAS float* Wr = (LAS float*)(F.lds);
    LAS int* l_e = (LAS int*)(F.lds + 147456);
    LAS int* l_rank = l_e + 256;
    LAS float* l_w = (LAS float*)(l_rank + 256);
    LAS unsigned* lcnt = (LAS unsigned*)(l_w + 256);
    LAS unsigned* gbase = lcnt + 32;
    for (int idx = tid; idx < 4096; idx += NTHREADS) { const int k = idx >> 2, g = idx & 3; Wr[g * 1024 + k] = a->ffn_norm[k] * a->w_group[idx]; }
    for (int idx = tid; idx < 32768; idx += NTHREADS) { const int k = idx >> 5, e = idx & 31; Wr[(4 + e) * 1024 + k] = a->ffn_norm[k] * a->w_router[idx]; }
    f32x4 gn[4];
#pragma unroll
    for (int j = 0; j < 4; ++j) gn[j] = ((const f32x4*)a->ffn_norm)[64 * j + lane];
    for (int chunk = F.bid; chunk < T / 128; chunk += F.G) {
        if (tid < 32) lcnt[tid] = 0u;
        __syncthreads();
        for (int i = 0; i < 16; ++i) {
            const int lr = F.wave * 16 + i, m = chunk * 128 + lr;
            const f32x4* xr = (const f32x4*)(x1 + (size_t)m * D) + lane;
            f32x4 v[4]; float s = 0.f;
#pragma unroll
            for (int j = 0; j < 4; ++j) { v[j] = xr[64 * j]; s += (v[j].x * v[j].x + v[j].y * v[j].y) + (v[j].z * v[j].z + v[j].w * v[j].w); }
            const float rs = 1.0f / sqrtf(wave_sum(s) * (1.f / D) + RMS_EPS);
            uint2* o8 = (uint2*)(hb + (size_t)m * D) + lane;
#pragma unroll
            for (int j = 0; j < 4; ++j) { uint2 o; o.x = pk2(v[j].x * rs * gn[j].x, v[j].y * rs * gn[j].y); o.y = pk2(v[j].z * rs * gn[j].z, v[j].w * rs * gn[j].w); o8[64 * j] = o; }
            float lg[36];
#pragma unroll
            for (int o = 0; o < 36; ++o) { float acc = 0.f;
#pragma unroll
                for (int j = 0; j < 4; ++j) { const f32x4 w = *(const LAS f32x4*)(Wr + o * 1024 + 256 * j + 4 * lane); acc += (v[j].x * w.x + v[j].y * w.y) + (v[j].z * w.z + v[j].w * w.w); }
                lg[o] = wave_sum(acc) * rs; }
            int gs = 0; float gmax = lg[0];
#pragma unroll
            for (int g = 1; g < 4; ++g) if (lg[g] > gmax) { gmax = lg[g]; gs = g; }
            float gden = 0.f;
#pragma unroll
            for (int g = 0; g < 4; ++g) gden += __expf(lg[g] - gmax);
            const float pgrp = 1.f / gden;
            float il[8];
#pragma unroll
            for (int e = 0; e < 8; ++e) { float vsel = lg[4 + e];
#pragma unroll
                for (int g = 1; g < 4; ++g) vsel = (gs == g) ? lg[4 + 8 * g + e] : vsel;
                il[e] = vsel; }
            int i0 = 0; float m0 = il[0];
#pragma unroll
            for (int e = 1; e < 8; ++e) if (il[e] > m0) { m0 = il[e]; i0 = e; }
            int i1 = -1; float m1 = -INFINITY;
#pragma unroll
            for (int e = 0; e < 8; ++e) if (e != i0 && il[e] > m1) { m1 = il[e]; i1 = e; }
            const float e1 = __expf(m1 - m0), w0 = pgrp / (1.f + e1), w1 = pgrp * e1 / (1.f + e1);
            if (lane == 0) {
                const int ex0 = gs * 8 + i0, ex1 = gs * 8 + i1;
                l_e[lr * 2] = ex0; l_e[lr * 2 + 1] = ex1; l_w[lr * 2] = w0; l_w[lr * 2 + 1] = w1;
                l_rank[lr * 2] = (int)atomicAdd((unsigned*)&lcnt[ex0], 1u); l_rank[lr * 2 + 1] = (int)atomicAdd((unsigned*)&lcnt[ex1], 1u);
            }
        }
        __syncthreads();
        if (tid < 32) gbase[tid] = __hip_atomic_fetch_add(gcnt + tid, lcnt[tid], __ATOMIC_RELAXED, __HIP_MEMORY_SCOPE_AGENT);
        __syncthreads();
        if (tid < 256) { const int m2 = chunk * 256 + tid; const int e = l_e[tid];
            tok_e[m2] = e; tok_w[m2] = l_w[tid]; tok_r[m2] = (int)gbase[e] + l_rank[tid]; }
        __syncthreads();
    }
}

__device__ __forceinline__ void p6_gather(KArgs a, const Ctx& F) {
    LANE_TID;
    unsigned char* ws = a->ws;
    const bf16* hb = (const bf16*)(ws + WS_HB); bf16* xs = (bf16*)(ws + WS_XS);
    const int* tok_e = (const int*)(ws + WS_TOKE); const float* tok_w = (const float*)(ws + WS_TOKW); const int* tok_r = (const int*)(ws + WS_TOKR);
    int* rowmap = (int*)(ws + WS_ROWMAP); float* roww = (float*)(ws + WS_ROWW); int* tile_e = (int*)(ws + WS_TILEE);
    const unsigned* gcnt = (const unsigned*)(ws + WS_CTL) + CW_CNT; unsigned* ntw = (unsigned*)(ws + WS_CTL) + CW_NT;
    LAS int* off = (LAS int*)(F.lds);
    LAS int* cntl = off + 64;
    if (tid == 0) { int o = 0;
        for (int e = 0; e < NE; ++e) { const int c = (int)__hip_atomic_load(gcnt + e, __ATOMIC_RELAXED, __HIP_MEMORY_SCOPE_AGENT); off[e] = o; cntl[e] = c; o += ((c + 255) >> 8) << 8; }
        off[NE] = o; }
    __syncthreads();
    if (F.bid == 0) {
        const int nt = off[NE] >> 8;
        if (tid == 0) __hip_atomic_store(ntw, (unsigned)nt, __ATOMIC_RELAXED, __HIP_MEMORY_SCOPE_AGENT);
        for (int mt = tid; mt < nt; mt += NTHREADS) { int e = 0;
            for (int k = 1; k < NE; ++k) if (off[k] <= mt * 256) e = k;
            tile_e[mt] = e; }
        for (int e = 0; e < NE; ++e) for (int r = off[e] + cntl[e] + tid; r < off[e + 1]; r += NTHREADS) { rowmap[r] = 2 * T; roww[r] = 0.f; }
    }
    const int gw = F.bid * NWAVES + F.wave, NGW = F.G * NWAVES;
    for (int p = gw; p < 2 * T; p += NGW) {
        const int e = tok_e[p], r = off[e] + tok_r[p], t = p >> 1;
        const v4u* src = (const v4u*)(hb + (size_t)t * D); v4u* dst = (v4u*)(xs + (size_t)r * D);
        const v4u w0 = src[lane], w1 = src[64 + lane];
        dst[lane] = w0; dst[64 + lane] = w1;
        if (lane == 0) { rowmap[r] = p; roww[r] = tok_w[p]; }
    }
}

__device__ __forceinline__ void p9_final(KArgs a, const Ctx& F) {
    LANE_TID;
    const bf16* y2 = (const bf16*)(a->ws + WS_Y2);
    const int gw = F.bid * NWAVES + F.wave, NGW = F.G * NWAVES;
    f32x4 gn[4];
#pragma unroll
    for (int j = 0; j < 4; ++j) gn[j] = ((const f32x4*)a->final_norm)[64 * j + lane];
    for (int m = gw; m < T; m += NGW) {
        f32x4* xr = (f32x4*)(a->out + (size_t)m * D) + lane;
        const uint2* ya = (const uint2*)(y2 + (size_t)(2 * m) * D) + lane; const uint2* yb = (const uint2*)(y2 + (size_t)(2 * m + 1) * D) + lane;
        f32x4 v[4]; float s = 0.f;
#pragma unroll
        for (int j = 0; j < 4; ++j) { v[j] = xr[64 * j]; const uint2 p = ya[64 * j], q = yb[64 * j];
            v[j].x += bflo(p.x) + bflo(q.x); v[j].y += bfhi(p.x) + bfhi(q.x); v[j].z += bflo(p.y) + bflo(q.y); v[j].w += bfhi(p.y) + bfhi(q.y);
            s += (v[j].x * v[j].x + v[j].y * v[j].y) + (v[j].z * v[j].z + v[j].w * v[j].w); }
        const float rs = 1.0f / sqrtf(wave_sum(s) * (1.f / D) + RMS_EPS);
#pragma unroll
        for (int j = 0; j < 4; ++j) { f32x4 o; o.x = v[j].x * rs * gn[j].x; o.y = v[j].y * rs * gn[j].y; o.z = v[j].z * rs * gn[j].z; o.w = v[j].w * rs * gn[j].w; xr[64 * j] = o; }
    }
}

#ifndef MK_ONE_LAUNCH
#define MK_ONE_LAUNCH 1
#endif
constexpr int N_PHASES = 10;
__global__ void __launch_bounds__(NTHREADS, 2) mega_fwd(Args a_by_value) {
    const KArgs ka = (KArgs)__builtin_amdgcn_kernarg_segment_ptr();
#define KA() ({ KArgs q_ = ka; asm volatile("" : "+s"(q_)); q_; })
    extern __shared__ __attribute__((aligned(16))) unsigned char lds_raw[];
    Ctx F; F.lds = (LAS unsigned char*)lds_raw; F.wave = __builtin_amdgcn_readfirstlane((int)(threadIdx.x >> 6)); F.G = gridDim.x; F.bid = blockIdx.x;
#ifndef PH_MASK
#define PH_MASK 0x3ff
#endif
#define IN(k) (((PH_MASK >> (k)) & 1) && KA()->ph_lo <= (k) && (k) < KA()->ph_hi)
#define WSP() (KA()->ws)
#if MK_ONE_LAUNCH
#define MKBAR() XcdBarrier{(unsigned*)(WSP() + WS_CTL) + CW_BAR, xb_xcc_id(), (volatile LAS unsigned*)(F.lds + LDS_CTL_OFF)}
    {
        const int lane0 = lane_id(); const bool leader0 = (F.wave == 0 && lane0 == 0);
        if (F.wave == 0) ((LAS unsigned*)(F.lds + LDS_CTL_OFF))[lane0] = 0u;
        __syncthreads();
        (void)xcd_barrier_post((unsigned*)(WSP() + WS_CTL) + CW_BAR, (volatile LAS unsigned*)(F.lds + LDS_CTL_OFF), leader0);
        cg::this_grid().sync();
    }
#define SEAM(k) do { if (IN(k) && IN((k) + 1)) { const bool leader_ = (F.wave == 0 && lane_id() == 0); const XcdBarrier bar_ = MKBAR(); xcd_barrier(bar_, leader_, (unsigned)gridDim.x); } } while (0)
#else
#define SEAM(k) do { } while (0)
#endif
    if (IN(0)) p0_prologue(KA(), F);
    SEAM(0);
    if (IN(1)) {
        unsigned char* ws = WSP();
        pg8::Gemm g{(const pg8::bf16_t*)(ws + WS_HB), (const pg8::bf16_t*)(ws + WS_WIN), D, D};
        pg8::StaticOrder S; S.init(T, NP, F.G, F.bid);
        pg8::EpiStoreBf16 E{(pg8::bf16_t*)(ws + WS_P), NP, 512, attn_body::C2};
        pg8::gemm_phase<pg8::EpiStoreBf16, pg8::StaticOrder, true, true>(F.lds, g, S, E, F.wave);
    }
    SEAM(1);
    if (IN(2)) p2_kmean(KA(), F);
    SEAM(2);
    if (IN(3)) {
        p3_gdn_naive(KA(), F);
        unsigned char* ws = WSP();
        const attn_body::bf16* Pb = (const attn_body::bf16*)(ws + WS_P);
        const attn_body::AttnTensors AT{Pb + PC_MQ, Pb + PC_MK, Pb + PC_MV, (attn_body::bf16*)(ws + WS_P) + PC_MQ, (const float*)(ws + WS_KMEAN)};
        const attn_body::StaticOrder S(F.G, F.bid);
        attn_body::attn_phase<attn_body::StaticOrder>((char*)lds_raw, AT, S, F.wave);
    }
    SEAM(3);
    if (IN(4)) {
        unsigned char* ws = WSP();
        pg8::Gemm g{(const pg8::bf16_t*)(ws + WS_P), (const pg8::bf16_t*)(ws + WS_WOUT), NP, D};
        pg8::StaticOrder S; S.init(T, D, F.G, F.bid);
        pg8::EpiResF32 E{KA()->x, KA()->out, D};
        pg8::gemm_phase<pg8::EpiResF32, pg8::StaticOrder, true, true>(F.lds, g, S, E, F.wave);
    }
    SEAM(4);
    if (IN(5)) p5_router(KA(), F);
    SEAM(5);
    if (IN(6)) p6_gather(KA(), F);
    SEAM(6);
    if (IN(7)) {
        unsigned char* ws = WSP();
        const int nt = (int)__hip_atomic_load((const unsigned*)(ws + WS_CTL) + CW_NT, __ATOMIC_RELAXED, __HIP_MEMORY_SCOPE_AGENT);
        pg8::Gemm g{(const pg8::bf16_t*)(ws + WS_XS), (const pg8::bf16_t*)(ws + WS_WGU), D, D};
        pg8::MoeOrder S{(const int*)(ws + WS_TILEE), nt, 2, F.G, F.bid};
        pg8::EpiGateUp E{(pg8::bf16_t*)(ws + WS_HID), (const float*)(ws + WS_ROWW)};
        pg8::gemm_phase<pg8::EpiGateUp, pg8::MoeOrder, true, true>(F.lds, g, S, E, F.wave);
    }
    SEAM(7);
    if (IN(8)) {
        unsigned char* ws = WSP();
        const int nt = (int)__hip_atomic_load((const unsigned*)(ws + WS_CTL) + CW_NT, __ATOMIC_RELAXED, __HIP_MEMORY_SCOPE_AGENT);
        pg8::Gemm g{(const pg8::bf16_t*)(ws + WS_HID), (const pg8::bf16_t*)(ws + WS_WD), FF, FF};
        pg8::MoeOrder S{(const int*)(ws + WS_TILEE), nt, 4, F.G, F.bid};
        pg8::EpiDown E{(pg8::bf16_t*)(ws + WS_Y2), (const int*)(ws + WS_ROWMAP)};
        pg8::gemm_phase<pg8::EpiDown, pg8::MoeOrder, true, true>(F.lds, g, S, E, F.wave);
    }
    SEAM(8);
    if (IN(9)) p9_final(KA(), F);
#undef IN
#undef SEAM
}

extern "C" void kernel_launch(void* const* d_in, const int* in_sizes, int n_in, void* d_out, int out_size, void* d_ws, size_t ws_size, hipStream_t stream) {
    static int grid = 0;
    if (grid == 0) {
        int dev = 0, cus = 0, per_cu = 0;
        hipGetDevice(&dev); hipDeviceGetAttribute(&cus, hipDeviceAttributeMultiprocessorCount, dev);
        hipFuncSetAttribute((const void*)mega_fwd, hipFuncAttributeMaxDynamicSharedMemorySize, LDS_BYTES);
        hipOccupancyMaxActiveBlocksPerMultiprocessor(&per_cu, (const void*)mega_fwd, NTHREADS, LDS_BYTES);
        if (per_cu < 1) { fprintf(stderr, "kernel_launch: occupancy query says %d blocks/CU\n", per_cu); per_cu = 1; }
        grid = cus * 1;
        if (ws_size < WS_END) { fprintf(stderr, "kernel_launch: workspace too small (%zu < %zu)\n", ws_size, (size_t)WS_END); grid = -1; }
    }
    if (grid < 0) return;
    hipMemsetAsync((char*)d_ws + WS_CTL, 0, CTL_ZERO_BYTES, stream);
    Args a{};
    a.x = (const float*)d_in[0]; a.attn_norm = (const float*)d_in[1]; a.w_in = (const float*)d_in[2]; a.conv_w = (const float*)d_in[3]; a.A_log = (const float*)d_in[4];
    a.dt_bias = (const float*)d_in[5]; a.gdn_norm = (const float*)d_in[6]; a.w_out = (const float*)d_in[7]; a.ffn_norm = (const float*)d_in[8]; a.w_group = (const float*)d_in[9];
    a.w_router = (const float*)d_in[10]; a.w_gate = (const float*)d_in[11]; a.w_up = (const float*)d_in[12]; a.w_down = (const float*)d_in[13]; a.final_norm = (const float*)d_in[14];
    a.out = (float*)d_out; a.ws = (unsigned char*)d_ws;
#if MK_ONE_LAUNCH
    a.ph_lo = 0; a.ph_hi = N_PHASES;
    void* args[] = {&a};
    hipError_t e = hipLaunchCooperativeKernel((const void*)mega_fwd, dim3(grid), dim3(NTHREADS), args, LDS_BYTES, stream);
    if (e != hipSuccess) fprintf(stderr, "cooperative launch failed: %s (grid %d)\n", hipGetErrorString(e), grid);
#else
    for (int p = 0; p < N_PHASES; ++p) { a.ph_lo = p; a.ph_hi = p + 1; hipLaunchKernelGGL(mega_fwd, dim3(grid), dim3(NTHREADS), LDS_BYTES, stream, a); }
#endif
}
```

```cpp
#include <hip/hip_runtime.h>
#include <hip/hip_cooperative_groups.h>
#include <cstdio>
#include <cstdint>
namespace cg = cooperative_groups;
__device__ __forceinline__ int lane_id_opaque() { int l; asm volatile("v_mbcnt_lo_u32_b32 %0, -1, 0\n\tv_mbcnt_hi_u32_b32 %0, -1, %0" : "=v"(l)); return l; }
namespace pg8 {
#define PG8_LAS __attribute__((address_space(3)))
typedef unsigned short bf16_t;
typedef short bf16x8 __attribute__((ext_vector_type(8)));
typedef float f32x4 __attribute__((ext_vector_type(4)));
typedef unsigned u32x4 __attribute__((ext_vector_type(4)));
constexpr int BM = 256, BK = 64, HALF = 128, HTB = HALF * BK * 2  , STAGE_BYTES = 8 * HTB, NXCD = 8, WGM = 8;

__host__ __device__ __forceinline__ int lds_byte(int r, int c) { const int st = (r >> 4) * 2 + (c >> 5), rr = r & 15, cc = c & 31, ob = rr * 64 + cc * 2; return st * 1024 + (ob ^ (((ob >> 9) & 1) << 5)); }
__host__ __device__ __forceinline__ void stage_rc(int b, int& R, int& C) { const int st = b / 1024, sb = b % 1024, swz = sb ^ (((sb >> 9) & 1) << 5); R = (st >> 1) * 16 + swz / 64; C = (st & 1) * 32 + (swz % 64) / 2; }
__host__ __device__ __forceinline__ int perm32(int rho) { const int n = rho >> 4, i = rho & 15; return 8 * (i >> 2) + 4 * n + (i & 3); }

struct Unit { int pm, pn; };
struct Gemm { const bf16_t* A; const bf16_t* Bt; int lda, K; };

struct StaticOrder {
    int nM, nN, nwg, G, c;
    __host__ __device__ void init(int M, int N, int G_, int c_) { nM = M / BM; nN = N / BM; nwg = nM * nN; G = G_; c = c_; }
    __host__ __device__ bool next(int i, Unit& u) const {
        const long L = (long)i * G + c; if (L >= nwg) return false;
        int wgid = (int)L; { const int q = nwg / NXCD, r = nwg % NXCD, xcd = wgid % NXCD, off = wgid / NXCD; wgid = (xcd < r ? xcd * (q + 1) : r * (q + 1) + (xcd - r) * q) + off; }
        const int nig = WGM * nN, gid = wgid / nig, fm = gid * WGM, gsz = (nM - fm) < WGM ? (nM - fm) : WGM;
        u.pm = fm + ((wgid % nig) % gsz); u.pn = (wgid % nig) / gsz; return true;
    }
    __device__ __forceinline__ void a_ready(const Unit&) const {}
    __device__ __forceinline__ void done(const Unit&) const {}
};

__device__ __forceinline__ unsigned cvt_pk_bf16(float lo, float hi) { unsigned r; asm volatile("v_cvt_pk_bf16_f32 %0, %1, %2" : "=v"(r) : "v"(lo), "v"(hi)); return r; }

struct EpiStoreBf16 {
    static constexpr bool PERM = true, AFTER_DRAIN = false;
    bf16_t* O; int ldc; int scale_cols; float scale0;
    __device__ __forceinline__ void operator()(const f32x4 (&acc)[2][2][4][2], const Unit& u, int wr, int wc, int fr, int fq) const {
        const int row0 = u.pm * BM + wr * 64 + fr; const int colt = u.pn * BM;
        const float sc = (colt < scale_cols) ? scale0 : 1.f;
        const int col0 = colt + wc * 32 + 8 * fq;
#pragma unroll
        for (int ai = 0; ai < 2; ++ai)
#pragma unroll
            for (int m = 0; m < 4; ++m) { bf16_t* rowp = O + (size_t)(row0 + ai * HALF + m * 16) * ldc + col0;
#pragma unroll
                for (int bj = 0; bj < 2; ++bj) { const f32x4 v0 = acc[ai][bj][m][0] * sc, v1 = acc[ai][bj][m][1] * sc;
                    u32x4 w; w.x = cvt_pk_bf16(v0[0], v0[1]); w.y = cvt_pk_bf16(v0[2], v0[3]); w.z = cvt_pk_bf16(v1[0], v1[1]); w.w = cvt_pk_bf16(v1[2], v1[3]);
                    *(u32x4*)(rowp + bj * HALF) = w; } }
    }
};
struct EpiResF32 {
    static constexpr bool PERM = false, AFTER_DRAIN = false;
    const float* base; float* out; int ldc;
    __device__ __forceinline__ void operator()(const f32x4 (&acc)[2][2][4][2], const Unit& u, int wr, int wc, int fr, int fq) const {
        const int row0 = u.pm * BM + wr * 64 + fr, col0 = u.pn * BM + wc * 32 + 4 * fq;
#pragma unroll
        for (int ai = 0; ai < 2; ++ai)
#pragma unroll
            for (int m = 0; m < 4; ++m) { const size_t off = (size_t)(row0 + ai * HALF + m * 16) * ldc + col0;
#pragma unroll
                for (int bj = 0; bj < 2; ++bj)
#pragma unroll
                    for (int n = 0; n < 2; ++n) { const f32x4 b = *(const f32x4*)(base + off + bj * HALF + n * 16); *(f32x4*)(out + off + bj * HALF + n * 16) = b + acc[ai][bj][m][n]; } }
    }
};
struct EpiGateUp {
    static constexpr bool PERM = true, AFTER_DRAIN = false;
    bf16_t* hid; const float* roww;
    __device__ __forceinline__ void operator()(const f32x4 (&acc)[2][2][4][2], const Unit& u, int wr, int wc, int fr, int fq) const {
        const int row0 = u.pm * BM + wr * 64 + fr; const int hc0 = (u.pn & 1) * 128 + 16 * wc + 4 * fq;
#pragma unroll
        for (int ai = 0; ai < 2; ++ai)
#pragma unroll
            for (int m = 0; m < 4; ++m) { const int r = row0 + ai * HALF + m * 16; const float w = roww[r]; bf16_t* rowp = hid + (size_t)r * 256 + hc0;
#pragma unroll
                for (int bj = 0; bj < 2; ++bj) { const f32x4 v0 = acc[ai][bj][m][0], v1 = acc[ai][bj][m][1];
                    const float h0 = v0[0] / (1.f + __expf(-v0[0])) * v0[1] * w, h1 = v0[2] / (1.f + __expf(-v0[2])) * v0[3] * w;
                    const float h2 = v1[0] / (1.f + __expf(-v1[0])) * v1[1] * w, h3 = v1[2] / (1.f + __expf(-v1[2])) * v1[3] * w;
                    uint2 o; o.x = cvt_pk_bf16(h0, h1); o.y = cvt_pk_bf16(h2, h3);
                    *(uint2*)(rowp + bj * 64) = o; } }
    }
};
struct EpiDown {
    static constexpr bool PERM = true, AFTER_DRAIN = false;
    bf16_t* y2; const int* rowmap;
    __device__ __forceinline__ void operator()(const f32x4 (&acc)[2][2][4][2], const Unit& u, int wr, int wc, int fr, int fq) const {
        const int row0 = u.pm * BM + wr * 64 + fr; const int col0 = (u.pn & 3) * 256 + wc * 32 + 8 * fq;
#pragma unroll
        for (int ai = 0; ai < 2; ++ai)
#pragma unroll
            for (int m = 0; m < 4; ++m) { int r = row0 + ai * HALF + m * 16; asm volatile("" : "+v"(r)); const int dst = rowmap[r];
                bf16_t* rowp = y2 + (size_t)dst * 1024 + col0;
#pragma unroll
                for (int bj = 0; bj < 2; ++bj) { const f32x4 v0 = acc[ai][bj][m][0], v1 = acc[ai][bj][m][1];
                    u32x4 w; w.x = cvt_pk_bf16(v0[0], v0[1]); w.y = cvt_pk_bf16(v0[2], v0[3]); w.z = cvt_pk_bf16(v1[0], v1[1]); w.w = cvt_pk_bf16(v1[2], v1[3]);
                    *(u32x4*)(rowp + bj * HALF) = w; } }
    }
};
struct MoeOrder {
    const int* tile_e; int ntiles, nsub, G, c;
    __device__ __forceinline__ bool next(int i, Unit& u) const {
        const int L = i * G + c; if (L >= ntiles * nsub) return false;
        const int mt = L / nsub, j = L - mt * nsub; u.pm = mt; u.pn = tile_e[mt] * nsub + j; return true;
    }
    __device__ __forceinline__ void a_ready(const Unit&) const {}
    __device__ __forceinline__ void done(const Unit&) const {}
};

template <class Epi, class Sched, bool ALIGN_EPI = false, bool SP2 = false>
__device__ __forceinline__ void gemm_phase(PG8_LAS unsigned char* lds, const Gemm g, const Sched& S, const Epi& E, const int wid) {
    const int lane = lane_id_opaque(), tid = wid * 64 + lane, wr = wid >> 2, wc = wid & 3, fr = lane & 15, fq = lane >> 4;
    const int K = g.K, nt = K / BK, lda = g.lda;
    unsigned voffA[2], voffB[2];
#pragma unroll
    for (int i = 0; i < 2; ++i) { int R, C; stage_rc(tid * 16 + i * 8192, R, C); const int Rb = Epi::PERM ? ((R & ~31) + perm32(R & 31)) : R;
        voffA[i] = (unsigned)(R * lda + C) * 2u; voffB[i] = (unsigned)(Rb * K + C) * 2u; }
    const size_t kstep = (size_t)(BK * 2);
    const size_t hstepA = (size_t)HALF * lda * 2, hstepB = (size_t)HALF * K * 2;
    const size_t tstepA = 2 * hstepA, tstepB = 2 * hstepB;
    const unsigned ldsw = (unsigned)wid * 1024u;
    const int aoff = lds_byte(wr * 64 + fr, fq * 8), boff = lds_byte(wc * 32 + fr, fq * 8);
#define PG8_SA(b, h) (((b) * 2 + (h)) * HTB)
#define PG8_SB(b, h) ((4 + (b) * 2 + (h)) * HTB)
#define PG8_STAGE(bufoff, gbase, voff) do { _Pragma("unroll") for (int _i = 0; _i < 2; ++_i) \
        __builtin_amdgcn_global_load_lds((const unsigned*)((const char*)(gbase) + (voff)[_i]), (PG8_LAS unsigned*)(lds + (bufoff) + ldsw + _i * 8192), 16, 0, 0); } while (0)
#define PG8_LDA(dst, b, h) do { _Pragma("unroll") for (int m = 0; m < 4; ++m) _Pragma("unroll") for (int k = 0; k < 2; ++k) dst[m][k] = *(const PG8_LAS bf16x8*)(lds + PG8_SA(b, h) + aoff + m * 2048 + k * 1024); } while (0)
#define PG8_LDB(dst, b, h) do { _Pragma("unroll") for (int n = 0; n < 2; ++n) _Pragma("unroll") for (int k = 0; k < 2; ++k) dst[n][k] = *(const PG8_LAS bf16x8*)(lds + PG8_SB(b, h) + boff + n * 2048 + k * 1024); } while (0)
#define PG8_MMA(ai, bj, At, Bt) do { __builtin_amdgcn_s_setprio(1); _Pragma("unroll") for (int m = 0; m < 4; ++m) _Pragma("unroll") for (int n = 0; n < 2; ++n) _Pragma("unroll") for (int k = 0; k < 2; ++k) \
        acc[ai][bj][m][n] = __builtin_amdgcn_mfma_f32_16x16x32_bf16(Bt[n][k], At[m][k], acc[ai][bj][m][n], 0, 0, 0); __builtin_amdgcn_s_setprio(0); } while (0)
#define PG8_WAIT_V(n) asm volatile("s_waitcnt vmcnt(" #n ")" ::: "memory")
#define PG8_WAIT_L(n) asm volatile("s_waitcnt lgkmcnt(" #n ")" ::: "memory")
#define PG8_BAR __builtin_amdgcn_s_barrier()
#define PG8_SCHED __builtin_amdgcn_sched_barrier(0)
    Unit cur, nxt; int ui = 0;
    if (!S.next(0, cur)) return;
    f32x4 acc[2][2][4][2];
#pragma unroll
    for (int a = 0; a < 2; ++a)
#pragma unroll
        for (int b = 0; b < 2; ++b)
#pragma unroll
            for (int m = 0; m < 4; ++m)
#pragma unroll
                for (int n = 0; n < 2; ++n) acc[a][b][m][n] = (f32x4){0.f, 0.f, 0.f, 0.f};
    bf16x8 At[4][2], B0[2][2], B1[2][2];
    const char* cA = (const char*)g.A + (size_t)cur.pm * tstepA; const char* cB = (const char*)g.Bt + (size_t)cur.pn * tstepB;
    S.a_ready(cur);
    if constexpr (SP2) {
        PG8_STAGE(PG8_SB(0, 0), cB, voffB); PG8_STAGE(PG8_SB(0, 1), cB + hstepB, voffB); PG8_STAGE(PG8_SA(0, 0), cA, voffA); PG8_STAGE(PG8_SA(0, 1), cA + hstepA, voffA);
        if (wr == 1) PG8_BAR;
        PG8_WAIT_V(2); PG8_BAR;
        PG8_STAGE(PG8_SB(1, 0), cB + kstep, voffB); PG8_STAGE(PG8_SA(1, 0), cA + kstep, voffA); PG8_STAGE(PG8_SB(1, 1), cB + hstepB + kstep, voffB);
        PG8_WAIT_V(6); PG8_BAR;
    } else {
        PG8_STAGE(PG8_SB(0, 0), cB, voffB); PG8_STAGE(PG8_SA(0, 0), cA, voffA); PG8_STAGE(PG8_SB(0, 1), cB + hstepB, voffB); PG8_STAGE(PG8_SA(0, 1), cA + hstepA, voffA);
        if (wr == 1) PG8_BAR;
        PG8_WAIT_V(4); PG8_BAR;
        PG8_STAGE(PG8_SB(1, 0), cB + kstep, voffB); PG8_STAGE(PG8_SA(1, 0), cA + kstep, voffA); PG8_STAGE(PG8_SB(1, 1), cB + hstepB + kstep, voffB);
        PG8_WAIT_V(6); PG8_BAR;
    }
    for (;;) {
        const bool has_next = S.next(ui + 1, nxt);
        const char* nA = has_next ? (const char*)g.A + (size_t)nxt.pm * tstepA : cA; const char* nB = has_next ? (const char*)g.Bt + (size_t)nxt.pn * tstepB : cB;
        for (int t = 0; t < nt; t += 2) {
            const bool last = (t == nt - 2);
            const char* a1 = cA + (size_t)(t + 1) * kstep;
            const char* a2 = last ? nA : cA + (size_t)(t + 2) * kstep; const char* b2 = last ? nB : cB + (size_t)(t + 2) * kstep;
            const char* a3 = a2 + kstep; const char* b3 = b2 + kstep;
            if (last && has_next) S.a_ready(nxt);
            if constexpr (SP2) {
            PG8_LDB(B0, 0, 0); PG8_LDB(B1, 0, 1); PG8_SCHED; PG8_LDA(At, 0, 0); PG8_STAGE(PG8_SA(1, 1), a1 + hstepA, voffA);
            PG8_WAIT_V(8); PG8_WAIT_L(0); PG8_BAR; PG8_MMA(0, 0, At, B0); PG8_MMA(0, 1, At, B1); PG8_BAR; PG8_SCHED;
            PG8_LDA(At, 0, 1); PG8_STAGE(PG8_SB(0, 0), b2, voffB); PG8_STAGE(PG8_SB(0, 1), b2 + hstepB, voffB); PG8_STAGE(PG8_SA(0, 0), a2, voffA);
            PG8_WAIT_V(8); PG8_WAIT_L(0); PG8_BAR; PG8_MMA(1, 0, At, B0); PG8_MMA(1, 1, At, B1); PG8_BAR; PG8_SCHED;
            PG8_LDB(B0, 1, 0); PG8_LDB(B1, 1, 1); PG8_SCHED; PG8_LDA(At, 1, 0); PG8_STAGE(PG8_SA(0, 1), a2 + hstepA, voffA);
            PG8_WAIT_V(8); PG8_WAIT_L(0); PG8_BAR; PG8_MMA(0, 0, At, B0); PG8_MMA(0, 1, At, B1); PG8_BAR; PG8_SCHED;
            PG8_LDA(At, 1, 1); PG8_STAGE(PG8_SB(1, 0), b3, voffB); PG8_STAGE(PG8_SB(1, 1), b3 + hstepB, voffB); PG8_STAGE(PG8_SA(1, 0), a3, voffA);
            PG8_WAIT_V(8); PG8_WAIT_L(0); PG8_BAR; PG8_MMA(1, 0, At, B0); PG8_MMA(1, 1, At, B1); PG8_BAR; PG8_SCHED;
            } else {
            PG8_LDB(B0, 0, 0); PG8_SCHED; PG8_LDA(At, 0, 0); PG8_STAGE(PG8_SA(1, 1), a1 + hstepA, voffA);
            PG8_WAIT_L(8); PG8_BAR; PG8_WAIT_L(0); PG8_MMA(0, 0, At, B0); PG8_BAR; PG8_SCHED;
            PG8_LDB(B1, 0, 1); PG8_STAGE(PG8_SB(0, 0), b2, voffB);
            PG8_BAR; PG8_WAIT_L(0); PG8_MMA(0, 1, At, B1); PG8_BAR;
            PG8_LDA(At, 0, 1); PG8_STAGE(PG8_SA(0, 0), a2, voffA);
            PG8_BAR; PG8_WAIT_L(0); PG8_MMA(1, 0, At, B0); PG8_BAR; PG8_SCHED;
            PG8_STAGE(PG8_SB(0, 1), b2 + hstepB, voffB);
            PG8_WAIT_V(6); PG8_BAR; PG8_MMA(1, 1, At, B1); PG8_BAR;
            PG8_LDB(B0, 1, 0); PG8_SCHED; PG8_LDA(At, 1, 0); PG8_STAGE(PG8_SA(0, 1), a2 + hstepA, voffA);
            PG8_WAIT_L(8); PG8_BAR; PG8_WAIT_L(0); PG8_MMA(0, 0, At, B0); PG8_BAR; PG8_SCHED;
            PG8_LDB(B1, 1, 1); PG8_STAGE(PG8_SB(1, 0), b3, voffB);
            PG8_BAR; PG8_WAIT_L(0); PG8_MMA(0, 1, At, B1); PG8_BAR;
            PG8_LDA(At, 1, 1); PG8_STAGE(PG8_SA(1, 0), a3, voffA);
            PG8_BAR; PG8_WAIT_L(0); PG8_MMA(1, 0, At, B0); PG8_BAR; PG8_SCHED;
            PG8_STAGE(PG8_SB(1, 1), b3 + hstepB, voffB);
            PG8_WAIT_V(6); PG8_BAR; PG8_MMA(1, 1, At, B1); PG8_BAR;
            }
        }
        if constexpr (ALIGN_EPI) { if (wr == 0) PG8_BAR; }
        if constexpr (!Epi::AFTER_DRAIN) { E(acc, cur, wr, wc, fr, fq); S.done(cur); }
        if (!has_next) break;
#pragma unroll
        for (int a = 0; a < 2; ++a)
#pragma unroll
            for (int b = 0; b < 2; ++b)
#pragma unroll
                for (int m = 0; m < 4; ++m)
#pragma unroll
                    for (int n = 0; n < 2; ++n) acc[a][b][m][n] = (f32x4){0.f, 0.f, 0.f, 0.f};
        cur = nxt; cA = nA; cB = nB; ++ui;
        if constexpr (ALIGN_EPI) { if (wr == 1) PG8_BAR; }
    }
    PG8_WAIT_V(0);
    if constexpr (!ALIGN_EPI) { if (wr == 0) PG8_BAR; }
    PG8_BAR;
    if constexpr (Epi::AFTER_DRAIN) { E.fused(acc, cur, wr, wc, fr, fq, lds, wid, lane); S.done(cur); }
#undef PG8_SA
#undef PG8_SB
#undef PG8_STAGE
#undef PG8_LDA
#undef PG8_LDB
#undef PG8_MMA
#undef PG8_WAIT_V
#undef PG8_WAIT_L
#undef PG8_BAR
#undef PG8_SCHED
}
}

#define SBAR() __builtin_amdgcn_sched_barrier(0)
#include <hip/hip_bf16.h>
#include <cmath>
namespace attn_body {
using bf16=__hip_bfloat16;
using bf16x8=__attribute__((ext_vector_type(8)))short;
using s16x4=__attribute__((ext_vector_type(4)))short;
using f32x16=__attribute__((ext_vector_type(16)))float;
using u32x4=__attribute__((ext_vector_type(4)))unsigned;
constexpr int BATCH=16,NHEAD=8,SEQ=2048,D=64,DM=3584;
constexpr int NW=8,QBLK=32,QB=QBLK*NW,KVBLK=64,NQB=SEQ/QB;
constexpr int ATTN_PITCH=DM, ATTN_UNIT_ROWS=QB;
__device__ __forceinline__ int crow(int r,int hi){return (r&3)+8*(r>>2)+4*hi;}
__device__ __forceinline__ float bf2f_s(short v){return __builtin_bit_cast(float,((unsigned)(unsigned short)v)<<16);}
#define SBAR() __builtin_amdgcn_sched_barrier(0)
__device__ __forceinline__ void cmask(f32x16&p0,f32x16&p1,int jb,int qrel,int hi){
  const float NEG=-INFINITY; int kb=64*jb+4*hi;
  #pragma unroll
  for(int r=0;r<16;++r){int kv=kb+(r&3)+8*(r>>2); if(kv>qrel)p0[r]=NEG; if(kv+32>qrel)p1[r]=NEG;}
}

constexpr int NSLOT=3, SLOTB=8192;
constexpr int LDS_K=0, LDS_V=NSLOT*SLOTB, LDS_WS=2*NSLOT*SLOTB, LDS_OST=LDS_WS+NW*64*4, LDS_BYTES=LDS_OST+NW*4096;
constexpr float C2=0.125f*1.4426950408889634f;
__device__ __forceinline__ void glds16(const void*gsrc,unsigned lds_dst){unsigned keep;
  asm volatile("s_mov_b32 %0, m0\n\ts_mov_b32 m0, %2\n\ts_nop 0\n\tglobal_load_lds_dwordx4 %1, off\n\ts_mov_b32 m0, %0":"=&s"(keep):"v"(gsrc),"s"(lds_dst):"memory");}
__device__ __forceinline__ float max3f(float a,float b,float c){float r;asm("v_max3_f32 %0, %1, %2, %3":"=v"(r):"v"(a),"v"(b),"v"(c));return r;}
__device__ __forceinline__ float max2f(float a,float b){float r;asm("v_max_f32_e32 %0, %1, %2":"=v"(r):"v"(a),"v"(b));return r;}
__device__ __forceinline__ float fadd_s(float a,float b){float r;asm("v_add_f32_e32 %0, %1, %2":"=v"(r):"v"(a),"v"(b));return r;}
__device__ __forceinline__ float fsub_s(float a,float b){float r;asm("v_sub_f32_e32 %0, %1, %2":"=v"(r):"v"(a),"v"(b));return r;}
typedef float f32x2_t __attribute__((ext_vector_type(2))); typedef __bf16 bf16x2_t __attribute__((ext_vector_type(2)));
__device__ __forceinline__ unsigned cvtpk_s(float lo,float hi){f32x2_t v={lo,hi};bf16x2_t b=__builtin_convertvector(v,bf16x2_t);return __builtin_bit_cast(unsigned,b);}
#define WAIT_BAR(N) asm volatile("s_waitcnt vmcnt(" #N ") lgkmcnt(0)\n\ts_barrier":::"memory")

__device__ __forceinline__ void qkt(f32x16&p0,f32x16&p1,const char*Kslot,const bf16x8*qr,const f32x16&negm,int r32,int hi){
  const char*kb=Kslot+hi*1024+r32*16;
  #pragma unroll
  for(int d0=0;d0<4;++d0){
    const bf16x8 b0=*reinterpret_cast<const bf16x8*>(kb+d0*2048);
    const bf16x8 b1=*reinterpret_cast<const bf16x8*>(kb+d0*2048+512);
    if(d0==0){p0=__builtin_amdgcn_mfma_f32_32x32x16_bf16(b0,qr[0],negm,0,0,0);p1=__builtin_amdgcn_mfma_f32_32x32x16_bf16(b1,qr[0],negm,0,0,0);}
    else{p0=__builtin_amdgcn_mfma_f32_32x32x16_bf16(b0,qr[d0],p0,0,0,0);p1=__builtin_amdgcn_mfma_f32_32x32x16_bf16(b1,qr[d0],p1,0,0,0);}}
}
typedef __attribute__((address_space(3))) const char* lds_cptr;
typedef short v4i16_t __attribute__((ext_vector_type(4)));
__device__ __forceinline__ void kload8(bf16x8*kf,lds_cptr kp){
  kf[0]=*(const __attribute__((address_space(3))) bf16x8*)(kp);      kf[1]=*(const __attribute__((address_space(3))) bf16x8*)(kp+512);
  kf[2]=*(const __attribute__((address_space(3))) bf16x8*)(kp+2048); kf[3]=*(const __attribute__((address_space(3))) bf16x8*)(kp+2560);
  kf[4]=*(const __attribute__((address_space(3))) bf16x8*)(kp+4096); kf[5]=*(const __attribute__((address_space(3))) bf16x8*)(kp+4608);
  kf[6]=*(const __attribute__((address_space(3))) bf16x8*)(kp+6144); kf[7]=*(const __attribute__((address_space(3))) bf16x8*)(kp+6656);
}
__device__ __forceinline__ void kload2(bf16x8*kf,lds_cptr kp,int j){ kf[2*j]=*(const __attribute__((address_space(3))) bf16x8*)(kp+j*2048); kf[2*j+1]=*(const __attribute__((address_space(3))) bf16x8*)(kp+j*2048+512); }
__device__ __forceinline__ s16x4 vtr(lds_cptr p){ return __builtin_bit_cast(s16x4,__builtin_amdgcn_ds_read_tr16_b64_v4i16((__attribute__((address_space(3))) v4i16_t*)p)); }
__device__ __forceinline__ float rowmax(const f32x16&p0,const f32x16&p1){
  float a=max3f(p0[0],p0[1],p1[0]),b=max3f(p0[2],p0[3],p1[1]);a=max3f(a,p1[2],p1[3]);
  #pragma unroll
  for(int r=4;r<16;r+=4){a=max3f(a,p0[r],p0[r+1]);b=max3f(b,p0[r+2],p0[r+3]);a=max3f(a,p1[r],p1[r+1]);b=max3f(b,p1[r+2],p1[r+3]);}
  const float m=max2f(a,b);
  auto rr=__builtin_amdgcn_permlane32_swap(__float_as_uint(m),__float_as_uint(m),false,false);
  return max2f(__uint_as_float(rr[0]),__uint_as_float(rr[1]));
}
__device__ __forceinline__ void pv(f32x16*o,int vb,bf16x8 pa0,bf16x8 pa1,bf16x8 pa2,bf16x8 pa3){
  #pragma unroll
  for(int d0=0;d0<2;++d0){s16x4 lo[4],hi[4];
    #pragma unroll
    for(int ks=0;ks<4;++ks){
      asm volatile("ds_read_b64_tr_b16 %0,%1 offset:%c2":"=&v"(lo[ks]):"v"(vb),"i"(d0*4096+ks*1024):"memory");
      asm volatile("ds_read_b64_tr_b16 %0,%1 offset:%c2":"=&v"(hi[ks]):"v"(vb),"i"(d0*4096+ks*1024+512):"memory");}
    asm volatile("s_waitcnt lgkmcnt(0)":::"memory");SBAR();
    #define PK(k) (bf16x8){lo[k][0],lo[k][1],lo[k][2],lo[k][3],hi[k][0],hi[k][1],hi[k][2],hi[k][3]}
    o[d0]=__builtin_amdgcn_mfma_f32_32x32x16_bf16(pa0,PK(0),o[d0],0,0,0);
    o[d0]=__builtin_amdgcn_mfma_f32_32x32x16_bf16(pa1,PK(1),o[d0],0,0,0);
    o[d0]=__builtin_amdgcn_mfma_f32_32x32x16_bf16(pa2,PK(2),o[d0],0,0,0);
    o[d0]=__builtin_amdgcn_mfma_f32_32x32x16_bf16(pa3,PK(3),o[d0],0,0,0);
    #undef PK
  }
}

#ifndef ATTN_STORE16
#define ATTN_STORE16(p,v) (*(u32x4*)(p)=(v))
#endif
template<int THRL> __device__ __forceinline__ void attn_unit(int b,int h,int qb,const bf16*Q,const bf16*__restrict__ K,const bf16*__restrict__ V,bf16*O,const float*kmean,char*shm,const int wid){
  const int lane=lane_id_opaque(),r32=lane&31,hi=lane>>5;
  const long rowbase=(long)b*SEQ; const int q0=qb*QB;
  const bf16*Qw=Q+(rowbase+q0+wid*QBLK)*DM+h*D;
  const bf16*Kh=K+rowbase*DM+h*D,*Vh=V+rowbase*DM+h*D;
  const unsigned lds0=(unsigned)(uintptr_t)shm;
  float*wsf=(float*)(shm+LDS_WS)+wid*64;
  const bf16*ksrc=Kh+(long)lane*DM+wid*8;
  const bf16*vsrc=Vh+(long)(16*(wid&3)+(lane>>2))*DM+(wid>>2)*32+(lane&3)*8;
  const unsigned kdst=lds0+LDS_K+wid*1024, vdst=lds0+LDS_V+wid*1024;
  #define DMA_K(t,slot) glds16(ksrc+(long)(t)*KVBLK*DM,(unsigned)__builtin_amdgcn_readfirstlane(kdst+(slot)))
  #define DMA_V(t,slot) glds16(vsrc+(long)(t)*KVBLK*DM,(unsigned)__builtin_amdgcn_readfirstlane(vdst+(slot)))
  const int vb0=(int)(lds0+LDS_V)+((lane>>4)&1)*32+(lane&3)*8+(4*hi+((lane&15)>>2))*64;
  const char*Kbase=shm+LDS_K; bf16x8 kf[8];
  const lds_cptr shm3=(lds_cptr)shm; const lds_cptr kp0=shm3+LDS_K+hi*1024+r32*16; const lds_cptr vp0=shm3+LDS_V+((lane>>4)&1)*32+(lane&3)*8+(4*hi+((lane&15)>>2))*64;
  const int NT=(q0+QB)/KVBLK;
  DMA_K(0,0);DMA_V(0,0);DMA_K(1,SLOTB);
  bf16x8 qr[4];
  #pragma unroll
  for(int d0=0;d0<4;++d0)qr[d0]=*reinterpret_cast<const bf16x8*>(&Qw[(long)r32*DM+d0*16+hi*8]);
  unsigned selmask=(qb<=3)?((1u<<qb)-1u):0u;
  if(qb>3){ float gate[7];
    #pragma unroll
    for(int j=0;j<7;++j){ gate[j]=-INFINITY;
      if(j<qb){ const float*km=kmean+((long)((b*NHEAD+h)*(SEQ/QB)+j))*D+hi*8; float sg=0.f;
        #pragma unroll
        for(int d0=0;d0<4;++d0){ const float4 k0=*(const float4*)(km+d0*16),k1=*(const float4*)(km+d0*16+4); const bf16x8 qv=qr[d0];
          sg+=bf2f_s(qv[0])*k0.x+bf2f_s(qv[1])*k0.y+bf2f_s(qv[2])*k0.z+bf2f_s(qv[3])*k0.w+bf2f_s(qv[4])*k1.x+bf2f_s(qv[5])*k1.y+bf2f_s(qv[6])*k1.z+bf2f_s(qv[7])*k1.w; }
        sg+=__shfl_xor(sg,32); gate[j]=sg; } }
    #pragma unroll
    for(int rnk=0;rnk<3;++rnk){ int best=0; float bv=-INFINITY;
      #pragma unroll
      for(int j=0;j<7;++j){ const bool ok=(j<qb)&&!((selmask>>j)&1u)&&(gate[j]>bv); if(ok){bv=gate[j];best=j;} }
      selmask|=1u<<best; } }
  ((unsigned*)wsf)[32+r32]=selmask;
  float mhat=0.f,l_reg=0.f;f32x16 o[2];o[0]=f32x16{};o[1]=f32x16{};const f32x16 negm=f32x16{};
  const int qrel=wid*QBLK+r32;
  #define SELM() (((const unsigned*)wsf)[32+r32])
  #define CMASK(P0,P1,t) do{int jb_=(t)-(NT-4); if(jb_>=0)cmask(P0,P1,jb_,qrel,hi); else if(!((SELM()>>((t)>>2))&1u)){ _Pragma("unroll") for(int r_=0;r_<16;++r_){P0[r_]=-INFINITY;P1[r_]=-INFINITY;} } }while(0)
  bool resc=false;
  #define START(P0,P1) do{ const float rm=rowmax(P0,P1); resc=false; \
    { const float dl=(rm>-1e30f)?rm:0.f; mhat=fadd_s(mhat,dl); \
      _Pragma("unroll") for(int r=0;r<16;++r){P0[r]=fsub_s(P0[r],dl);P1[r]=fsub_s(P1[r],dl);} \
      } \
    _Pragma("unroll") for(int r=0;r<16;++r)P0[r]=__builtin_amdgcn_exp2f(P0[r]); }while(0)
  #define RESC() do{ if(resc){ asm volatile("s_waitcnt lgkmcnt(0)":::"memory"); \
      _Pragma("unroll") for(int d_=0;d_<2;++d_) _Pragma("unroll") for(int r=0;r<16;++r)o[d_][r]*=wsf[crow(r,hi)]; } }while(0)
  f32x16 pA0,pA1,pB0,pB1;
  int sl_prev=0,sl_cur=0,sl_next=SLOTB;
  #define ROT() do{sl_prev=sl_cur;sl_cur=sl_next;sl_next=(sl_next==(NSLOT-1)*SLOTB)?0:sl_next+SLOTB;}while(0)
  DMA_K(2,2*SLOTB);
  WAIT_BAR(3);
  qkt(pA0,pA1,Kbase,qr,negm,r32,hi);asm volatile("s_nop 15\n\ts_nop 7":"+v"(pA0),"+v"(pA1));CMASK(pA0,pA1,0);
  START(pA0,pA1);
  _Pragma("unroll") for(int r=0;r<16;++r)pA1[r]=__builtin_amdgcn_exp2f(pA1[r]);
  WAIT_BAR(0);
  DMA_K(3,0);DMA_V(1,SLOTB);
  ROT();
  kload8(kf,kp0+sl_cur);
  WAIT_BAR(2);
  s16x4 vlo[8],vhi[8]; u32x4 pw0,pw1,pw2,pw3;
  #define PKW(P,B) cvtpk_s(P[B],P[B+1])
  #define PAF(k) __builtin_bit_cast(bf16x8,pw##k)
  #define VFR(i) (bf16x8){vlo[i][0],vlo[i][1],vlo[i][2],vlo[i][3],vhi[i][0],vhi[i][1],vhi[i][2],vhi[i][3]}
  #define PIN(x) asm volatile("":"+v"(x))
  #define MX3(a,b,c) __builtin_fmaxf(__builtin_fmaxf((a),(b)),(c))
  #define GAPA(MF,A0,A1,A2,A3,W0,W1,PW) do{ MF; sacc+=A0; sacc+=A1; sacc+=A2; sacc+=A3; PIN(sacc); W0; W1; PIN(PW); SBAR(); }while(0)
  #define EX(v) __builtin_amdgcn_exp2f(v)
  #define EXB(v,HB) EX(v)
  #define GAPB(MF,X,B,HB) do{ MF; X[B]=EXB(X[B],HB); X[B+1]=EXB(X[B+1],HB); X[B+2]=EXB(X[B+2],HB); X[B+3]=EXB(X[B+3],HB); PIN(X); SBAR(); }while(0)
  #define VRD(i) do{ vlo[i]=vtr(vp_+(((i)>>2)*4096+((i)&3)*1024)); vhi[i]=vtr(vp_+(((i)>>2)*4096+((i)&3)*1024+512)); }while(0)
  #define KRD(G,j) do{ if(G){ kload2(kf,kp0+sl_next,j); SBAR(); } }while(0)
  #define STEP(C0,C1,P0,P1,t,GK,GV,GL,HB) do{ SBAR(); \
    const float bias_=(((t)<NT-4)&&!((SELM()>>((t)>>2))&1u))?-INFINITY:0.f; \
    const lds_cptr vp_=vp0+sl_prev; \
    VRD(0); SBAR(); float sacc=(P0[0]+P0[1]); \
    GAPA(C0=__builtin_amdgcn_mfma_f32_32x32x16_bf16(kf[0],qr[0],negm,0,0,0), P0[2],P0[3],P0[4],P0[5],     pw0[0]=PKW(P0,0), pw0[1]=PKW(P0,2), pw0); \
    VRD(4); SBAR(); GAPA(C1=__builtin_amdgcn_mfma_f32_32x32x16_bf16(kf[1],qr[0],negm,0,0,0), P0[6],P0[7],P0[8],P0[9],     pw0[2]=PKW(P0,4), pw0[3]=PKW(P0,6), pw0); \
    VRD(1); SBAR(); GAPA(C0=__builtin_amdgcn_mfma_f32_32x32x16_bf16(kf[2],qr[1],C0,0,0,0),   P0[10],P0[11],P0[12],P0[13], pw1[0]=PKW(P0,8), pw1[1]=PKW(P0,10), pw1); \
    VRD(5); SBAR(); GAPA(C1=__builtin_amdgcn_mfma_f32_32x32x16_bf16(kf[3],qr[1],C1,0,0,0),   P0[14],P0[15],P1[0],P1[1],   pw1[2]=PKW(P0,12),pw1[3]=PKW(P0,14), pw1); \
    VRD(2); SBAR(); GAPA(C0=__builtin_amdgcn_mfma_f32_32x32x16_bf16(kf[4],qr[2],C0,0,0,0),   P1[2],P1[3],P1[4],P1[5],     pw2[0]=PKW(P1,0), pw2[1]=PKW(P1,2), pw2); \
    VRD(6); SBAR(); GAPA(C1=__builtin_amdgcn_mfma_f32_32x32x16_bf16(kf[5],qr[2],C1,0,0,0),   P1[6],P1[7],P1[8],P1[9],     pw2[2]=PKW(P1,4), pw2[3]=PKW(P1,6), pw2); \
    VRD(3); SBAR(); GAPA(C0=__builtin_amdgcn_mfma_f32_32x32x16_bf16(kf[6],qr[3],C0,0,0,0),   P1[10],P1[11],P1[12],P1[13], pw3[0]=PKW(P1,8), pw3[1]=PKW(P1,10), pw3); \
    VRD(7); SBAR(); GAPA(C1=__builtin_amdgcn_mfma_f32_32x32x16_bf16(kf[7],qr[3],C1,0,0,0),   P1[14],P1[15],0.f,0.f,       pw3[2]=PKW(P1,12),pw3[3]=PKW(P1,14), pw3); \
    l_reg+=sacc; \
    if(GK){DMA_K((t)+3,sl_cur);} if(GV){DMA_V((t)+1,sl_next);} \
    CMASK(C0,C1,t); \
    { const float mb_=mhat-bias_; _Pragma("unroll") for(int r=0;r<16;++r){C0[r]-=mb_;C1[r]-=mb_;} } \
    { float a=MX3(C0[0],C0[1],C1[0]),b=MX3(C0[2],C0[3],C1[1]); a=MX3(a,C1[2],C1[3]); \
      _Pragma("unroll") for(int r=4;r<16;r+=4){a=MX3(a,C0[r],C0[r+1]);b=MX3(b,C0[r+2],C0[r+3]);a=MX3(a,C1[r],C1[r+1]);b=MX3(b,C1[r+2],C1[r+3]);} \
      float rm=__builtin_fmaxf(a,b); { auto rr=__builtin_amdgcn_permlane32_swap(__float_as_uint(rm),__float_as_uint(rm),false,false); rm=__builtin_fmaxf(__uint_as_float(rr[0]),__uint_as_float(rr[1])); } \
      resc=false; \
      if(__builtin_expect(__any(rm>(float)THRL),0)){ const float dl=__builtin_fmaxf(rm,0.f); mhat+=dl; \
        _Pragma("unroll") for(int r=0;r<16;++r){C0[r]-=dl;C1[r]-=dl;} \
        const float f=__builtin_amdgcn_exp2f(-dl); l_reg*=f; if(hi==0)wsf[r32]=f; resc=true; } } \
    SBAR(); \
    GAPB(o[0]=__builtin_amdgcn_mfma_f32_32x32x16_bf16(PAF(0),VFR(0),o[0],0,0,0), C0,0,HB); \
    GAPB(o[1]=__builtin_amdgcn_mfma_f32_32x32x16_bf16(PAF(0),VFR(4),o[1],0,0,0), C0,4,HB); \
    KRD(GL,0); GAPB(o[0]=__builtin_amdgcn_mfma_f32_32x32x16_bf16(PAF(1),VFR(1),o[0],0,0,0), C0,8,HB); \
    KRD(GL,1); GAPB(o[1]=__builtin_amdgcn_mfma_f32_32x32x16_bf16(PAF(1),VFR(5),o[1],0,0,0), C0,12,HB); \
    KRD(GL,2); GAPB(o[0]=__builtin_amdgcn_mfma_f32_32x32x16_bf16(PAF(2),VFR(2),o[0],0,0,0), C1,0,HB); \
    KRD(GL,3); GAPB(o[1]=__builtin_amdgcn_mfma_f32_32x32x16_bf16(PAF(2),VFR(6),o[1],0,0,0), C1,4,HB); \
    GAPB(o[0]=__builtin_amdgcn_mfma_f32_32x32x16_bf16(PAF(3),VFR(3),o[0],0,0,0), C1,8,HB); \
    GAPB(o[1]=__builtin_amdgcn_mfma_f32_32x32x16_bf16(PAF(3),VFR(7),o[1],0,0,0), C1,12,HB); \
    }while(0)
  int t=1;
  #undef CMASK
  #define CMASK(P0,P1,t) do{}while(0)
  for(;t+5<NT;t+=2){
    STEP(pB0,pB1,pA0,pA1,t,true,true,true,1);     WAIT_BAR(2); RESC(); ROT();
    STEP(pA0,pA1,pB0,pB1,t+1,true,true,true,1);   WAIT_BAR(2); RESC(); ROT();
  }
  #undef CMASK
  #define CMASK(P0,P1,t) do{int jb_=(t)-(NT-4); if(jb_>=0)cmask(P0,P1,jb_,qrel,hi);}while(0)
  #define ENDW(tt) do{ if((tt)+3<NT){WAIT_BAR(2);} else if((tt)+2<NT){WAIT_BAR(1);} else {WAIT_BAR(0);} }while(0)
  for(;t+1<NT;t+=2){
    STEP(pB0,pB1,pA0,pA1,t,(t+3<NT),(t+1<NT),(t+1<NT),1);       ENDW(t);   RESC(); ROT();
    STEP(pA0,pA1,pB0,pB1,t+1,(t+4<NT),(t+2<NT),(t+2<NT),1);     ENDW(t+1); RESC(); ROT();
  }
  STEP(pB0,pB1,pA0,pA1,NT-1,false,false,false,1); RESC();
  { float sacc=pB0[0]+pB0[1]; _Pragma("unroll") for(int r=2;r<16;++r)sacc+=pB0[r]; _Pragma("unroll") for(int r=0;r<16;++r)sacc+=pB1[r]; l_reg+=sacc;
    pw0=(u32x4){PKW(pB0,0),PKW(pB0,2),PKW(pB0,4),PKW(pB0,6)};pw1=(u32x4){PKW(pB0,8),PKW(pB0,10),PKW(pB0,12),PKW(pB0,14)};pw2=(u32x4){PKW(pB1,0),PKW(pB1,2),PKW(pB1,4),PKW(pB1,6)};pw3=(u32x4){PKW(pB1,8),PKW(pB1,10),PKW(pB1,12),PKW(pB1,14)};
    SBAR(); pv(o,vb0+sl_cur,PAF(0),PAF(1),PAF(2),PAF(3)); }
  #undef PKW
  #undef PAF
  #undef VFR
  #undef PIN
  #undef MX3
  #undef GAPA
  #undef GAPB
  #undef EX
  #undef EXB
  #undef VRD
  #undef KRD
  #undef STEP
  #undef ENDW
  {auto rr=__builtin_amdgcn_permlane32_swap(__float_as_uint(l_reg),__float_as_uint(l_reg),false,false);l_reg=__uint_as_float(rr[0])+__uint_as_float(rr[1]);}
  if(hi==0)wsf[32+r32]=l_reg;asm volatile("s_waitcnt lgkmcnt(0)":::"memory");
  float rli[16];
  #pragma unroll
  for(int r=0;r<16;++r)rli[r]=__builtin_amdgcn_rcpf(wsf[32+crow(r,hi)]);
  bf16*Ow=O+(rowbase+q0+wid*QBLK)*DM+h*D;
  { bf16*stg=(bf16*)(shm+LDS_OST)+wid*2048;
    #pragma unroll
    for(int r=0;r<16;++r){const int orow=crow(r,hi);
      #pragma unroll
      for(int d0=0;d0<2;++d0)stg[orow*64+d0*32+r32]=__float2bfloat16(o[d0][r]*rli[r]);}
    asm volatile("s_waitcnt lgkmcnt(0)":::"memory");
    #pragma unroll
    for(int i=0;i<4;++i){const int row=i*8+(lane>>3),ch=lane&7; const u32x4 v=*(const u32x4*)(stg+row*64+ch*8); ATTN_STORE16(Ow+(long)row*DM+ch*8,v);} }
  asm volatile("s_waitcnt lgkmcnt(0)\n\ts_barrier":::"memory");
  #undef DMA_K
  #undef DMA_V
  #undef CMASK
  #undef START
  #undef RESC
  #undef ROT
}
constexpr int ATTN_LDS_BYTES=LDS_BYTES;
struct AttnTensors { const bf16* Q; const bf16* K; const bf16* V; bf16* O; const float* kmean; };
struct AttnUnit { int bh; int qb; };
struct StaticOrder {
  int vcu, G;
  __device__ __forceinline__ explicit StaticOrder(int grid,int block):vcu((grid%8==0)?((block%8)*(grid/8)+block/8):block),G(grid){}
  __device__ __forceinline__ bool next(int i,AttnUnit&u)const{ const int L=(i>>2)*G+vcu; if(L>=BATCH*NHEAD*2)return false; const int s=L&1,k=i&3; u.bh=L>>1; u.qb=(k==0)?s:(k==1)?7-s:(k==2)?2+s:5-s; return true; }
  __device__ __forceinline__ void a_ready(const AttnUnit&)const{}
  __device__ __forceinline__ void done(const AttnUnit&)const{}
};
template<class Sched,int THRL=8> __device__ __forceinline__ void attn_phase(char*lds,const AttnTensors&T,const Sched&S,const int wid){
  AttnUnit u;
  for(int i=0;S.next(i,u);++i){ S.a_ready(u); attn_unit<THRL>(u.bh/NHEAD,u.bh%NHEAD,u.qb,T.Q,T.K,T.V,T.O,T.kmean,lds,wid); S.done(u); }
}
#undef SBAR
#undef WAIT_BAR
}

namespace gdn {
typedef short bf16x8 __attribute__((ext_vector_type(8)));
typedef float f32x4 __attribute__((ext_vector_type(4)));
typedef unsigned u32x4 __attribute__((ext_vector_type(4)));
constexpr int ITEM_BYTES = 73728, OFF_NW = 0, OFF_QD = 16384, OFF_KT = 32768, OFF_QK = 49152, OFF_UV = 57344;
__device__ __forceinline__ int afrag_off(int i, int k, int nks) { const int rt = i >> 4, r = i & 15, ks = k >> 5, kk = k & 31, g = (kk >> 2) & 3, j = 4 * (kk >> 4) + (kk & 3), l = 16 * g + r; return ((rt * nks + ks) * 64 + l) * 8 + j; }
typedef float f32x2_t __attribute__((ext_vector_type(2))); typedef __bf16 bf16x2_t __attribute__((ext_vector_type(2)));
__device__ __forceinline__ unsigned cvtpk(float lo, float hi) { f32x2_t v = {lo, hi}; bf16x2_t b = __builtin_convertvector(v, bf16x2_t); return __builtin_bit_cast(unsigned, b); }
__device__ __forceinline__ bf16x8 pack8(const f32x4& a, const f32x4& b) { u32x4 w; w.x = cvtpk(a[0], a[1]); w.y = cvtpk(a[2], a[3]); w.z = cvtpk(b[0], b[1]); w.w = cvtpk(b[2], b[3]); return __builtin_bit_cast(bf16x8, w); }
#define GLAS __attribute__((address_space(3)))

constexpr int L_KS = 0, L_QS = 17408, L_AM = 34816, L_QM = 52224, L_SC = 69632, L_IMG = 71680;
__device__ __forceinline__ void prep_phase(GLAS unsigned char* lds, const unsigned short* P, const float* gab, const float* conv_w, const float* A_log, const float* dt_bias,
                                           unsigned char* gws, float* glast_out, const int wave, const int G, const int bid) {
    GLAS unsigned short* KS = (GLAS unsigned short*)(lds + L_KS); GLAS unsigned short* QS = (GLAS unsigned short*)(lds + L_QS);
    GLAS float* AM = (GLAS float*)(lds + L_AM); GLAS float* QM = (GLAS float*)(lds + L_QM);
    GLAS float* sG = (GLAS float*)(lds + L_SC); GLAS float* sBeta = sG + 64; GLAS float* sGam = sG + 128; GLAS float* sKds = sG + 192; GLAS float* sNk = sG + 256; GLAS float* sNq = sG + 320; GLAS float* sQq = sG + 384;
    GLAS unsigned short* IMG0 = (GLAS unsigned short*)(lds + L_IMG); GLAS unsigned short* IMG1 = IMG0 + 8192; GLAS unsigned short* IMG2 = IMG0 + 16384;
    for (int it = bid; it < 2048; it += G) {
        const int lane = lane_id_opaque(), tid = wave * 64 + lane;
        const int m = tid >> 7, c = tid & 127, g4 = lane >> 4, c16 = lane & 15;
        const int h = it & 3, n = (it >> 2) & 31, b = it >> 7;
        const size_t row0 = (size_t)b * 2048 + n * 64;
        unsigned char* item = gws + (size_t)it * ITEM_BYTES;
        float val[64];
        if (m < 3) {
            const int ch = m * 512 + h * 128 + c;
            const unsigned short* px = P + row0 * 3584 + 2048 + ch;
            const float cw0 = conv_w[ch], cw1 = conv_w[1536 + ch], cw2 = conv_w[3072 + ch], cw3 = conv_w[4608 + ch];
            float x0 = 0.f, x1 = 0.f, x2 = 0.f;
            if (n > 0) { x0 = __builtin_bit_cast(float, (unsigned)(*(px - 3 * 3584)) << 16); x1 = __builtin_bit_cast(float, (unsigned)(*(px - 2 * 3584)) << 16); x2 = __builtin_bit_cast(float, (unsigned)(*(px - 3584)) << 16); }
#pragma unroll
            for (int i = 0; i < 64; ++i) { const float x3 = __builtin_bit_cast(float, (unsigned)px[(size_t)i * 3584] << 16);
                const float s = cw0 * x0 + cw1 * x1 + cw2 * x2 + cw3 * x3; val[i] = s / (1.f + __expf(-s)); x0 = x1; x1 = x2; x2 = x3; }
            if (m == 0) {
#pragma unroll
                for (int i = 0; i < 64; ++i) QS[i * 136 + c] = (unsigned short)(cvtpk(val[i], 0.f) & 0xffffu);
            } else if (m == 1) {
#pragma unroll
                for (int i = 0; i < 64; ++i) KS[i * 136 + c] = (unsigned short)(cvtpk(val[i], 0.f) & 0xffffu);
            }
        } else if (wave == 6) {
            const float ga = gab[(row0 + lane) * 8 + h], gb = gab[(row0 + lane) * 8 + 4 + h];
            const float xsp = ga + dt_bias[h]; const float sp = xsp > 20.f ? xsp : log1pf(__expf(xsp));
            float Gc = -__expf(A_log[h]) * sp;
#pragma unroll
            for (int o = 1; o < 64; o <<= 1) { const float t = __shfl_up(Gc, o); if (lane >= o) Gc += t; }
            const float Gl = __shfl(Gc, 63);
            sG[lane] = Gc; sBeta[lane] = 1.f / (1.f + __expf(-gb)); sGam[lane] = __expf(Gc); sKds[lane] = __expf(Gl - Gc);
            if (lane == 63) glast_out[it] = __expf(Gc);
        }
        __syncthreads();
#pragma unroll
        for (int kind = 0; kind < 2; ++kind)
#pragma unroll
            for (int tt = 0; tt < 2; ++tt) { const int Tt = wave * 2 + tt, ti = Tt >> 2, tj = Tt & 3;
                if (tj <= ti) { f32x4 acc = {0.f, 0.f, 0.f, 0.f};
                    const GLAS unsigned short* Ab = (kind ? QS : KS) + (16 * ti + c16) * 136 + 8 * g4; const GLAS unsigned short* Bb = KS + (16 * tj + c16) * 136 + 8 * g4;
#pragma unroll
                    for (int ks = 0; ks < 4; ++ks) acc = __builtin_amdgcn_mfma_f32_16x16x32_bf16(*(const GLAS bf16x8*)(Ab + 32 * ks), *(const GLAS bf16x8*)(Bb + 32 * ks), acc, 0, 0, 0);
                    GLAS float* Om = (kind ? QM : AM) + (16 * ti + 4 * g4) * 68 + 16 * tj + c16;
                    Om[0] = acc[0]; Om[68] = acc[1]; Om[136] = acc[2]; Om[204] = acc[3]; } }
        if (wave < 4) { f32x4 acc = {0.f, 0.f, 0.f, 0.f}; const GLAS unsigned short* Ab = QS + (16 * wave + c16) * 136 + 8 * g4;
#pragma unroll
            for (int ks = 0; ks < 4; ++ks) { const bf16x8 f = *(const GLAS bf16x8*)(Ab + 32 * ks); acc = __builtin_amdgcn_mfma_f32_16x16x32_bf16(f, f, acc, 0, 0, 0); }
            const int r = c16 - 4 * g4; const float dv = (r == 0) ? acc[0] : (r == 1) ? acc[1] : (r == 2) ? acc[2] : acc[3];
            if (r >= 0 && r < 4) sQq[16 * wave + c16] = dv; }
        __syncthreads();
        if (tid < 64) { sNk[tid] = 1.0f / sqrtf(AM[tid * 68 + tid] + 1e-6f); sNq[tid] = (1.0f / sqrtf(sQq[tid] + 1e-6f)) * 0.08838834764831845f; }
        __syncthreads();
#pragma unroll
        for (int e8 = 0; e8 < 8; ++e8) { const int e = tid + e8 * 512, i = e >> 6, j = e & 63;
            const float dec = (j <= i) ? __expf(sG[i] - sG[j]) : 0.f;
            const float kkv = AM[i * 68 + j], qkv = QM[i * 68 + j];
            AM[i * 68 + j] = (j < i) ? sBeta[i] * kkv * sNk[i] * sNk[j] * dec : 0.f;
            const float qkd = (j <= i) ? qkv * sNq[i] * sNk[j] * dec : 0.f;
            IMG2[afrag_off(i, j, 2)] = (unsigned short)(cvtpk(qkd, 0.f) & 0xffffu); }
        __syncthreads();
        if (m == 0) {
#pragma unroll
            for (int i = 0; i < 64; ++i) IMG1[afrag_off(i, c, 4)] = (unsigned short)(cvtpk(val[i] * sNq[i] * sGam[i], 0.f) & 0xffffu);
        } else if (m == 1) {
#pragma unroll
            for (int i = 0; i < 64; ++i) val[i] *= sNk[i];
            { const int rt = c >> 4, r = c & 15;
#pragma unroll
              for (int ks = 0; ks < 2; ++ks)
#pragma unroll
                for (int g = 0; g < 4; ++g) { u32x4 w;
                    { const int i0 = 32 * ks + 4 * g; w.x = cvtpk(val[i0] * sKds[i0], val[i0 + 1] * sKds[i0 + 1]); w.y = cvtpk(val[i0 + 2] * sKds[i0 + 2], val[i0 + 3] * sKds[i0 + 3]); }
                    { const int i1 = 32 * ks + 16 + 4 * g; w.z = cvtpk(val[i1] * sKds[i1], val[i1 + 1] * sKds[i1 + 1]); w.w = cvtpk(val[i1 + 2] * sKds[i1 + 2], val[i1 + 3] * sKds[i1 + 3]); }
                    *(u32x4*)(item + OFF_KT + (size_t)(((rt * 2 + ks) * 64 + 16 * g + r) * 16)) = w; } }
#pragma unroll
            for (int i = 0; i < 64; ++i) val[i] *= sBeta[i] * sGam[i];
        } else if (m == 2) {
#pragma unroll
            for (int i = 0; i < 64; ++i) val[i] *= sBeta[i];
        }
        if (m == 1 || m == 2) {
#pragma unroll
            for (int i = 1; i < 64; ++i) { float acc = val[i];
#pragma unroll
                for (int jj = 0; jj < (i + 3) / 4; ++jj) { const f32x4 a4 = *(const GLAS f32x4*)(AM + i * 68 + 4 * jj);
                    acc -= a4[0] * val[4 * jj]; acc -= a4[1] * val[4 * jj + 1]; acc -= a4[2] * val[4 * jj + 2]; acc -= a4[3] * val[4 * jj + 3]; }
                val[i] = acc; }
        }
        if (m == 1) {
#pragma unroll
            for (int i = 0; i < 64; ++i) IMG0[afrag_off(i, c, 4)] = (unsigned short)(cvtpk(-val[i], 0.f) & 0xffffu);
        } else if (m == 2) {
            const int vs = c >> 4;
#pragma unroll
            for (int i4 = 0; i4 < 16; ++i4) { const int rt = i4 >> 2, lg = i4 & 3; uint2 w; w.x = cvtpk(val[4 * i4], val[4 * i4 + 1]); w.y = cvtpk(val[4 * i4 + 2], val[4 * i4 + 3]);
                *(uint2*)(item + OFF_UV + (size_t)((((vs * 4 + rt) * 64) + 16 * lg + (c & 15)) * 8)) = w; }
        }
        __syncthreads();
#pragma unroll
        for (int q5 = 0; q5 < 5; ++q5) { const int q = tid + q5 * 512; const u32x4 w = *(const GLAS u32x4*)(lds + L_IMG + q * 16);
            *(u32x4*)(item + (q < 2048 ? (size_t)q * 16 : (size_t)OFF_QK + (size_t)(q - 2048) * 16)) = w; }
        __syncthreads();
    }
}

__device__ __forceinline__ void scan_phase(GLAS unsigned char* lds, unsigned short* P, const unsigned char* gws, const float* glast, const float* gdn_norm, const int wave, const int G, const int bid) {
    const int lane = lane_id_opaque(), g4 = lane >> 4, c16 = lane & 15, vs = wave;
    GLAS float* OL = (GLAS float*)lds;
    const float gn0 = gdn_norm[lane], gn1 = gdn_norm[64 + lane];
    for (int unit = bid; unit < 64; unit += G) {
        const int b = unit >> 2, h = unit & 3;
        f32x4 S[8];
#pragma unroll
        for (int i = 0; i < 8; ++i) S[i] = (f32x4){0.f, 0.f, 0.f, 0.f};
        for (int n = 0; n < 32; ++n) {
            const int it = (b * 32 + n) * 4 + h;
            const unsigned char* item = gws + (size_t)it * ITEM_BYTES;
            const bf16x8* NW = (const bf16x8*)(item + OFF_NW) + lane; const bf16x8* QD = (const bf16x8*)(item + OFF_QD) + lane;
            const bf16x8* KT = (const bf16x8*)(item + OFF_KT) + lane; const bf16x8* QK = (const bf16x8*)(item + OFF_QK) + lane;
            const uint2* UV = (const uint2*)(item + OFF_UV) + (vs * 4) * 64 + lane;
            const float gl = glast[it];
            f32x4 u[4], o[4]; bf16x8 Bs[4], Bu[2];
#pragma unroll
            for (int rt = 0; rt < 4; ++rt) { const uint2 w = UV[rt * 64]; u[rt] = (f32x4){__builtin_bit_cast(float, w.x << 16), __builtin_bit_cast(float, w.x & 0xffff0000u), __builtin_bit_cast(float, w.y << 16), __builtin_bit_cast(float, w.y & 0xffff0000u)}; o[rt] = (f32x4){0.f, 0.f, 0.f, 0.f}; }
#pragma unroll
            for (int ks = 0; ks < 4; ++ks) Bs[ks] = pack8(S[2 * ks], S[2 * ks + 1]);
#pragma unroll
            for (int rt = 0; rt < 4; ++rt)
#pragma unroll
                for (int ks = 0; ks < 4; ++ks) u[rt] = __builtin_amdgcn_mfma_f32_16x16x32_bf16(NW[(rt * 4 + ks) * 64], Bs[ks], u[rt], 0, 0, 0);
#pragma unroll
            for (int rt = 0; rt < 4; ++rt)
#pragma unroll
                for (int ks = 0; ks < 4; ++ks) o[rt] = __builtin_amdgcn_mfma_f32_16x16x32_bf16(QD[(rt * 4 + ks) * 64], Bs[ks], o[rt], 0, 0, 0);
            Bu[0] = pack8(u[0], u[1]); Bu[1] = pack8(u[2], u[3]);
#pragma unroll
            for (int rt = 0; rt < 4; ++rt)
#pragma unroll
                for (int kt = 0; kt < 2; ++kt) o[rt] = __builtin_amdgcn_mfma_f32_16x16x32_bf16(QK[(rt * 2 + kt) * 64], Bu[kt], o[rt], 0, 0, 0);
#pragma unroll
            for (int kt8 = 0; kt8 < 8; ++kt8) { S[kt8] = S[kt8] * gl;
#pragma unroll
                for (int kt = 0; kt < 2; ++kt) S[kt8] = __builtin_amdgcn_mfma_f32_16x16x32_bf16(KT[(kt8 * 2 + kt) * 64], Bu[kt], S[kt8], 0, 0, 0); }
#pragma unroll
            for (int rt = 0; rt < 4; ++rt) { GLAS float* op = OL + (16 * rt + 4 * g4) * 132 + 16 * vs + c16; op[0] = o[rt][0]; op[132] = o[rt][1]; op[264] = o[rt][2]; op[396] = o[rt][3]; }
            __syncthreads();
#pragma unroll
            for (int rr = 0; rr < 8; ++rr) { const int row = wave * 8 + rr; const float x0 = OL[row * 132 + lane], x1 = OL[row * 132 + 64 + lane];
                float ss = x0 * x0 + x1 * x1;
#pragma unroll
                for (int of = 1; of < 64; of <<= 1) ss += __shfl_xor(ss, of);
                const float rs = 1.0f / sqrtf(ss * (1.f / 128.f) + 1e-6f);
                unsigned short* pr = P + ((size_t)b * 2048 + n * 64 + row) * 3584 + 512 + h * 128;
                const float z0 = __builtin_bit_cast(float, (unsigned)pr[lane] << 16), z1 = __builtin_bit_cast(float, (unsigned)pr[64 + lane] << 16);
                pr[lane] = (unsigned short)(cvtpk(x0 * rs * gn0 * (z0 / (1.f + __expf(-z0))), 0.f) & 0xffffu);
                pr[64 + lane] = (unsigned short)(cvtpk(x1 * rs * gn1 * (z1 / (1.f + __expf(-z1))), 0.f) & 0xffffu); }
            __syncthreads();
        }
    }
}
#undef GLAS
}

#define GAS __attribute__((address_space(1)))
#define LAS __attribute__((address_space(3)))
typedef unsigned short bf16;
typedef unsigned v4u __attribute__((ext_vector_type(4)));
typedef float f32x4 __attribute__((ext_vector_type(4)));

constexpr int NWAVES = 8, NTHREADS = NWAVES * 64;
constexpr int NB = 16, NS = 2048, T = NB * NS, D = 1024;
constexpr int NP = 3584;
constexpr int PC_MQ = 0, PC_GZ = 512, PC_MK = 1024, PC_MV = 1536, PC_GQ = 2048, PC_GK = 2560, PC_GV = 3072;
constexpr int WIN_LD = 3592;
constexpr int MH = 8, MD = 64, MBLK = 256, MNB = NS / MBLK;
constexpr int GH = 4, GD = 128;
constexpr int NE = 32, FF = 256;
constexpr int MAXTILES = 288, MAXROWS = MAXTILES * 256;
constexpr float RMS_EPS = 1e-6f;

constexpr size_t MiB = 1u << 20;
constexpr size_t WS_CTL = 0, CTL_ZERO_BYTES = 1 * MiB;
constexpr size_t WS_WIN = 1 * MiB, WS_WOUT = 8 * MiB, WS_WGU = 10 * MiB, WS_WD = 42 * MiB;
constexpr size_t WS_GAB = 58 * MiB, WS_KMEAN = 59 * MiB;
constexpr size_t WS_TOKE = 60 * MiB, WS_TOKW = WS_TOKE + 256 * 1024, WS_TOKR = WS_TOKW + 256 * 1024, WS_ROWMAP = WS_TOKR + 256 * 1024, WS_ROWW = WS_ROWMAP + 512 * 1024, WS_TILEE = WS_ROWW + 512 * 1024;
constexpr size_t WS_HB = 64 * MiB;
constexpr size_t WS_P = 128 * MiB;
constexpr size_t WS_XS = WS_P;
constexpr size_t WS_HID = WS_P + 144 * MiB;
constexpr size_t WS_Y2 = 352 * MiB;
constexpr size_t WS_GDN = 352 * MiB;
constexpr size_t WS_GLAST = 59 * MiB + 512 * 1024;
constexpr size_t WS_END = 497 * MiB;
static_assert(WS_TILEE + 4096 <= WS_HB && WS_HID + (size_t)MAXROWS * 256 * 2 <= WS_Y2 && WS_P + (size_t)T * NP * 2 <= WS_Y2, "ws map");
constexpr int CW_CNT = 64;
constexpr int CW_NT = 128;
constexpr int CW_BAR = 4096;

constexpr int LDS_BYTES = 155648;
constexpr int LDS_CTL_OFF = LDS_BYTES - 256;

__device__ __forceinline__ unsigned f2bf(float f) { unsigned u = __builtin_bit_cast(unsigned, f); return (u + 0x7fffu + ((u >> 16) & 1u)) >> 16; }
__device__ __forceinline__ unsigned pk2(float lo, float hi) { return f2bf(lo) | (f2bf(hi) << 16); }
__device__ __forceinline__ float bflo(unsigned u) { return __builtin_bit_cast(float, u << 16); }
__device__ __forceinline__ float bfhi(unsigned u) { return __builtin_bit_cast(float, u & 0xffff0000u); }
__device__ __forceinline__ float bf2f(bf16 h) { return __builtin_bit_cast(float, (unsigned)h << 16); }
__device__ __forceinline__ float wave_sum(float v) {
#pragma unroll
    for (int o = 1; o < 64; o <<= 1) v += __shfl_xor(v, o);
    return v;
}
__device__ __forceinline__ float siluf(float x) { return x / (1.f + __expf(-x)); }

struct Args {
    const float* x; const float* attn_norm; const float* w_in; const float* conv_w; const float* A_log; const float* dt_bias; const float* gdn_norm; const float* w_out;
    const float* ffn_norm; const float* w_group; const float* w_router; const float* w_gate; const float* w_up; const float* w_down; const float* final_norm;
    float* out; unsigned char* ws; int ph_lo, ph_hi;
};

typedef const __attribute__((address_space(4))) Args* KArgs;
struct Ctx {
    LAS unsigned char* lds; int wave, G, bid;
};
__device__ __forceinline__ int lane_id() { return lane_id_opaque(); }
#define LANE_TID const int lane = lane_id(), tid = F.wave * 64 + lane; (void)tid; (void)lane


#define XB_TMO      128
#define XB_XCNT(j)  (256  + 64 * (j))
#define XB_XSUB(j)  (1280 + 64 * (j))
#define XB_XGEN(j)  (2304 + 64 * (j))
#define XB_TOP      3328
#define XB_TOPGEN   3392
#define XCD_BAR_WORDS 3456
#define XB_SPIN_CAP (1u << 20)
__device__ __forceinline__ unsigned xb_ld(unsigned* p)              { return __hip_atomic_load(p, __ATOMIC_RELAXED, __HIP_MEMORY_SCOPE_AGENT); }
__device__ __forceinline__ unsigned xb_add(unsigned* p, unsigned v) { return __hip_atomic_fetch_add(p, v, __ATOMIC_RELAXED, __HIP_MEMORY_SCOPE_AGENT); }
__device__ __forceinline__ unsigned xb_xcc_id() { return (unsigned)__builtin_amdgcn_s_getreg((3 << 11) | 20) & 0xFu; }
#define XB_SPIN(cond, bar) do { unsigned _sp = 0; while (cond) { __builtin_amdgcn_s_sleep(1); \
    if ((++_sp & 255u) == 0u) { if (xb_ld(&(bar)[XB_TMO])) break; if (_sp > XB_SPIN_CAP) { atomicAdd(&(bar)[XB_TMO], 1u); break; } } } } while (0)
struct XcdBarrier { unsigned* bar; unsigned x; volatile LAS unsigned* st; };
__device__ __forceinline__ XcdBarrier xcd_barrier_post(unsigned* bar, volatile LAS unsigned* st, bool leader) {
    XcdBarrier b; b.bar = bar; b.x = xb_xcc_id(); b.st = st;
    if (leader) (void)xb_add(&bar[XB_XCNT(b.x)], 1u);
    return b;
}
__device__ __forceinline__ void xcd_barrier_complete(unsigned* bar, unsigned x, unsigned G, unsigned& nloc, unsigned& nx) {
    unsigned sum, cnt, mine, sp = 0u;
    for (;;) {
        sum = 0u; cnt = 0u; mine = 0u;
#pragma unroll
        for (unsigned j = 0; j < 16; ++j) { const unsigned c = xb_ld(&bar[XB_XCNT(j)]); sum += c; cnt += (c > 0u) ? 1u : 0u; mine = (j == x) ? c : mine; }
        if (sum == G) break;
        __builtin_amdgcn_s_sleep(1);
        if ((++sp & 255u) == 0u) { if (xb_ld(&bar[XB_TMO])) break; if (sp > XB_SPIN_CAP) { atomicAdd(&bar[XB_TMO], 1u); break; } }
    }
    nloc = mine > 0u ? mine : 1u; nx = cnt > 0u ? cnt : 1u;
}
__device__ __forceinline__ void xcd_barrier(const XcdBarrier& b, bool leader, unsigned G) {
    asm volatile("s_waitcnt vmcnt(0)" ::: "memory");
    __syncthreads();
    if (leader) {
        unsigned* bar = b.bar;
        __builtin_amdgcn_s_waitcnt(0);
        unsigned nloc = b.st[0], nx = b.st[1];
        if (nloc == 0u) { xcd_barrier_complete(bar, b.x, G, nloc, nx); b.st[0] = nloc; b.st[1] = nx; }
        const unsigned old = xb_add(&bar[XB_XSUB(b.x)], 1u);
        const unsigned gen = old / nloc;
        if (old + 1u == (gen + 1u) * nloc) {
            __builtin_amdgcn_fence(__ATOMIC_RELEASE, "agent");
            asm volatile("s_waitcnt vmcnt(0)" ::: "memory");
            const unsigned og = xb_add(&bar[XB_TOP], 1u);
            const unsigned tg = og / nx;
            if (og + 1u == (tg + 1u) * nx) xb_add(&bar[XB_TOPGEN], 1u);
            else XB_SPIN(xb_ld(&bar[XB_TOPGEN]) == tg, bar);
            __builtin_amdgcn_fence(__ATOMIC_ACQUIRE, "agent");
            xb_add(&bar[XB_XGEN(b.x)], 1u);
            asm volatile("s_waitcnt vmcnt(0)" ::: "memory");
        } else {
            XB_SPIN(xb_ld(&bar[XB_XGEN(b.x)]) == gen, bar);
            __builtin_amdgcn_fence(__ATOMIC_ACQUIRE, "agent");
            asm volatile("s_waitcnt vmcnt(0)" ::: "memory");
        }
    }
    __syncthreads();
}

__device__ __forceinline__ void tr_item(const float* W, int ldn, int ncol0, int K, int nblk, bf16* WT, int row_off, int rmul, LAS float* scr, int item, int lane) {
    const int kb = item / nblk, nb = item - kb * nblk, k0 = 64 * kb, n0 = 32 * nb;
#pragma unroll 8
    for (int i = 0; i < 32; ++i) { const int kk = 2 * i + (lane >> 5); scr[kk * 33 + (lane & 31)] = W[(size_t)(k0 + kk) * ldn + ncol0 + n0 + (lane & 31)]; }
    asm volatile("s_waitcnt lgkmcnt(0)" ::: "memory");
    const int c = lane & 7;
#pragma unroll
    for (int j = 0; j < 4; ++j) { const int n = (lane >> 3) + 8 * j; const LAS float* s = scr + (8 * c) * 33 + n;
        v4u o; o.x = pk2(s[0 * 33], s[1 * 33]); o.y = pk2(s[2 * 33], s[3 * 33]); o.z = pk2(s[4 * 33], s[5 * 33]); o.w = pk2(s[6 * 33], s[7 * 33]);
        *(v4u*)(WT + (size_t)(row_off + rmul * (n0 + n)) * K + k0 + 8 * c) = o; }
    asm volatile("s_waitcnt lgkmcnt(0)" ::: "memory");
}

__device__ __forceinline__ void p0_prologue(KArgs a, const Ctx& F) {
    LANE_TID;
    unsigned char* ws = a->ws;
    bf16* Win_t = (bf16*)(ws + WS_WIN); bf16* Wout_t = (bf16*)(ws + WS_WOUT); bf16* Wgu_t = (bf16*)(ws + WS_WGU); bf16* Wd_t = (bf16*)(ws + WS_WD);
    LAS float* scr = (LAS float*)(F.lds + F.wave * 8704);
    const int gw = F.bid * NWAVES + F.wave, NGW = F.G * NWAVES;
    constexpr int I_S = 16 * 16;
    constexpr int I_IN = 16 * 112, I_OUT = 16 * 32, I_G = 16 * 8, I_D = 4 * 32;
    constexpr int NITEMS = I_IN + I_OUT + NE * I_G * 2 + NE * I_D;
    for (int it = gw; it < NITEMS; it += NGW) {
        int r = it;
        if (r < I_IN) {
            if (r < I_S)      { tr_item(a->w_in, WIN_LD, 0,    1024, 16, Win_t, PC_MQ, 1, scr, r, lane); continue; } r -= I_S;
            if (r < I_S)      { tr_item(a->w_in, WIN_LD, 3072, 1024, 16, Win_t, PC_GZ, 1, scr, r, lane); continue; } r -= I_S;
            if (r < I_S)      { tr_item(a->w_in, WIN_LD, 512,  1024, 16, Win_t, PC_MK, 1, scr, r, lane); continue; } r -= I_S;
            if (r < I_S)      { tr_item(a->w_in, WIN_LD, 1024, 1024, 16, Win_t, PC_MV, 1, scr, r, lane); continue; } r -= I_S;
            tr_item(a->w_in, WIN_LD, 1536, 1024, 48, Win_t, PC_GQ, 1, scr, r, lane); continue;
        }
        r -= I_IN;
        if (r < I_OUT) { tr_item(a->w_out, 1024, 0, 1024, 32, Wout_t, 0, 1, scr, r, lane); continue; }
        r -= I_OUT;
        if (r < NE * I_G * 2) { const int e = r / (2 * I_G), q = r - e * 2 * I_G, s = q / I_G, ii = q - s * I_G;
            tr_item((s ? a->w_up : a->w_gate) + (size_t)e * 1024 * 256, 256, 0, 1024, 8, Wgu_t, e * 512 + s, 2, scr, ii, lane); continue; }
        r -= NE * I_G * 2;
        { const int e = r / I_D, ii = r - e * I_D; tr_item(a->w_down + (size_t)e * 256 * 1024, 1024, 0, 256, 32, Wd_t, e * 1024, 1, scr, ii, lane); }
    }
    LAS float* W8t = (LAS float*)(F.lds + 73728);
    for (int idx = tid; idx < 8192; idx += NTHREADS) { const int k = idx >> 3, o = idx & 7; W8t[o * 1024 + k] = a->attn_norm[k] * a->w_in[(size_t)k * WIN_LD + 3584 + o]; }
    __syncthreads();
    bf16* hb = (bf16*)(ws + WS_HB); float* gab = (float*)(ws + WS_GAB);
    f32x4 gn[4];
#pragma unroll
    for (int j = 0; j < 4; ++j) gn[j] = ((const f32x4*)a->attn_norm)[64 * j + lane];
    for (int m = gw; m < T; m += NGW) {
        const f32x4* xr = (const f32x4*)(a->x + (size_t)m * D) + lane;
        f32x4 v[4]; float s = 0.f;
#pragma unroll
        for (int j = 0; j < 4; ++j) { v[j] = xr[64 * j]; s += (v[j].x * v[j].x + v[j].y * v[j].y) + (v[j].z * v[j].z + v[j].w * v[j].w); }
        const float rs = 1.0f / sqrtf(wave_sum(s) * (1.f / D) + RMS_EPS);
        uint2* o8 = (uint2*)(hb + (size_t)m * D) + lane;
#pragma unroll
        for (int j = 0; j < 4; ++j) { uint2 o; o.x = pk2(v[j].x * rs * gn[j].x, v[j].y * rs * gn[j].y); o.y = pk2(v[j].z * rs * gn[j].z, v[j].w * rs * gn[j].w); o8[64 * j] = o; }
        float myv = 0.f;
#pragma unroll
        for (int o = 0; o < 8; ++o) { float acc = 0.f;
#pragma unroll
            for (int j = 0; j < 4; ++j) { const f32x4 w = *(const LAS f32x4*)(W8t + o * 1024 + 256 * j + 4 * lane); acc += (v[j].x * w.x + v[j].y * w.y) + (v[j].z * w.z + v[j].w * w.w); }
            acc = wave_sum(acc) * rs; if (lane == o) myv = acc; }
        if (lane < 8) gab[(size_t)m * 8 + lane] = myv;
    }
}

__device__ __forceinline__ void p2_kmean(KArgs a, const Ctx& F) {
    LANE_TID;
    const bf16* P = (const bf16*)(a->ws + WS_P); float* kmean = (float*)(a->ws + WS_KMEAN);
    const int gw = F.bid * NWAVES + F.wave, NGW = F.G * NWAVES;
    for (int it = gw; it < NB * MH * MNB; it += NGW) {
        const int blk = it % MNB, h = (it / MNB) % MH, b = it / (MNB * MH);
        const bf16* kp = P + (size_t)(b * NS + blk * MBLK) * NP + PC_MK + h * MD + lane;
        float s = 0.f;
#pragma unroll 8
        for (int r = 0; r < MBLK; ++r) s += bf2f(kp[(size_t)r * NP]);
        kmean[(size_t)it * MD + lane] = s * (1.f / MBLK);
    }
}

__device__ __forceinline__ void p3_attn_naive(KArgs a, const Ctx& F) {
    LANE_TID;
    bf16* P = (bf16*)(a->ws + WS_P); const float* kmean = (const float*)(a->ws + WS_KMEAN);
    const int gw = F.bid * NWAVES + F.wave, NGW = F.G * NWAVES;
    for (int u = gw; u < NB * MH * (NS / 64); u += NGW) {
        const int qt = u % (NS / 64), h = (u / (NS / 64)) % MH, b = u / ((NS / 64) * MH);
        const int own = qt >> 2, t = qt * 64 + lane;
        const size_t rowbase = (size_t)b * NS;
        bf16* qp = P + (rowbase + t) * NP + PC_MQ + h * MD;
        unsigned qk[32];
#pragma unroll
        for (int i = 0; i < 8; ++i) { const v4u w = ((const v4u*)qp)[i]; qk[4 * i] = w.x; qk[4 * i + 1] = w.y; qk[4 * i + 2] = w.z; qk[4 * i + 3] = w.w; }
        float gate[7];
#pragma unroll
        for (int j = 0; j < 7; ++j) { gate[j] = -INFINITY;
            if (j < own) { const float* km = kmean + ((size_t)((b * MH + h) * MNB + j)) * MD; float s = 0.f;
#pragma unroll
                for (int d = 0; d < 32; ++d) s += bflo(qk[d]) * km[2 * d] + bfhi(qk[d]) * km[2 * d + 1];
                gate[j] = s; } }
        unsigned mask = 0u;
        if (own <= 3) mask = (1u << own) - 1u;
        else {
#pragma unroll
            for (int r = 0; r < 3; ++r) { int best = 0; float bv = -INFINITY;
#pragma unroll
                for (int j = 0; j < 7; ++j) { const bool ok = (j < own) && !((mask >> j) & 1u) && (gate[j] > bv); if (ok) { bv = gate[j]; best = j; } }
                mask |= 1u << best; }
        }
        float o[64];
#pragma unroll
        for (int d = 0; d < 64; ++d) o[d] = 0.f;
        float mrun = -1e30f, lrun = 0.f;
        const bf16* Kb = P + rowbase * NP + PC_MK + h * MD; const bf16* Vb = P + rowbase * NP + PC_MV + h * MD;
        for (int j = 0; j <= own; ++j) {
            const bool isown = (j == own);
            const bool sel = isown || ((mask >> j) & 1u);
            if (__ballot(sel) == 0ull) continue;
            const int nk = isown ? ((qt & 3) * 64 + 64) : MBLK;
#pragma unroll 1
            for (int kk = 0; kk < nk; ++kk) {
                const int key = j * MBLK + kk; const v4u* kp = (const v4u*)(Kb + (size_t)key * NP); float acc = 0.f;
#pragma unroll
                for (int c = 0; c < 8; ++c) { const v4u w = kp[c];
                    acc += bflo(qk[4 * c]) * bflo(w.x) + bfhi(qk[4 * c]) * bfhi(w.x) + bflo(qk[4 * c + 1]) * bflo(w.y) + bfhi(qk[4 * c + 1]) * bfhi(w.y)
                         + bflo(qk[4 * c + 2]) * bflo(w.z) + bfhi(qk[4 * c + 2]) * bfhi(w.z) + bflo(qk[4 * c + 3]) * bflo(w.w) + bfhi(qk[4 * c + 3]) * bfhi(w.w); }
                const bool valid = sel && (!isown || key <= t);
                const float sc = valid ? acc * 0.125f : -1e30f;
                const float mnew = fmaxf(mrun, sc), alpha = __expf(mrun - mnew);
                const float p = valid ? __expf(sc - mnew) : 0.f;
                lrun = lrun * alpha + p; mrun = mnew;
                const v4u* vp = (const v4u*)(Vb + (size_t)key * NP);
#pragma unroll
                for (int c = 0; c < 8; ++c) { const v4u w = vp[c];
                    o[8 * c + 0] = o[8 * c + 0] * alpha + p * bflo(w.x); o[8 * c + 1] = o[8 * c + 1] * alpha + p * bfhi(w.x); o[8 * c + 2] = o[8 * c + 2] * alpha + p * bflo(w.y); o[8 * c + 3] = o[8 * c + 3] * alpha + p * bfhi(w.y);
                    o[8 * c + 4] = o[8 * c + 4] * alpha + p * bflo(w.z); o[8 * c + 5] = o[8 * c + 5] * alpha + p * bfhi(w.z); o[8 * c + 6] = o[8 * c + 6] * alpha + p * bflo(w.w); o[8 * c + 7] = o[8 * c + 7] * alpha + p * bfhi(w.w); }
            }
        }
        const float inv = 1.f / lrun;
#pragma unroll
        for (int i = 0; i < 8; ++i) { v4u w; w.x = pk2(o[8 * i] * inv, o[8 * i + 1] * inv); w.y = pk2(o[8 * i + 2] * inv, o[8 * i + 3] * inv); w.z = pk2(o[8 * i + 4] * inv, o[8 * i + 5] * inv); w.w = pk2(o[8 * i + 6] * inv, o[8 * i + 7] * inv);
            ((v4u*)qp)[i] = w; }
    }
}

__device__ __forceinline__ void p3_gdn_naive(KArgs a, const Ctx& F) {
    LANE_TID;
    bf16* P = (bf16*)(a->ws + WS_P); const float* gab = (const float*)(a->ws + WS_GAB);
    LAS float* red = (LAS float*)(F.lds);
    LAS float* red2 = red + 16;
    LAS float* qs = red + 32;
    LAS float* ks = qs + 512;
    const int h = tid >> 7, c = tid & 127, wv = (tid >> 6) & 1;
    for (int b = F.bid; b < NB; b += F.G) {
        float S[128];
#pragma unroll
        for (int k = 0; k < 128; ++k) S[k] = 0.f;
        float xq0 = 0.f, xq1 = 0.f, xq2 = 0.f, xk0 = 0.f, xk1 = 0.f, xk2 = 0.f, xv0 = 0.f, xv1 = 0.f, xv2 = 0.f;
        float cq[4], ck[4], cv[4];
#pragma unroll
        for (int i = 0; i < 4; ++i) { cq[i] = a->conv_w[i * 1536 + h * 128 + c]; ck[i] = a->conv_w[i * 1536 + 512 + h * 128 + c]; cv[i] = a->conv_w[i * 1536 + 1024 + h * 128 + c]; }
        const float negA = -__expf(a->A_log[h]), dtb = a->dt_bias[h], gnorm = a->gdn_norm[c];
        for (int t = 0; t < NS; ++t) {
            const size_t row = (size_t)b * NS + t;
            bf16* pr = P + row * NP;
            const float xq3 = bf2f(pr[PC_GQ + h * 128 + c]), xk3 = bf2f(pr[PC_GK + h * 128 + c]), xv3 = bf2f(pr[PC_GV + h * 128 + c]);
            const float gz = bf2f(pr[PC_GZ + h * 128 + c]);
            const float ga = gab[row * 8 + h], gb = gab[row * 8 + 4 + h];
            const float qv = siluf(cq[0] * xq0 + cq[1] * xq1 + cq[2] * xq2 + cq[3] * xq3);
            const float kv = siluf(ck[0] * xk0 + ck[1] * xk1 + ck[2] * xk2 + ck[3] * xk3);
            const float vv = siluf(cv[0] * xv0 + cv[1] * xv1 + cv[2] * xv2 + cv[3] * xv3);
            xq0 = xq1; xq1 = xq2; xq2 = xq3; xk0 = xk1; xk1 = xk2; xk2 = xk3; xv0 = xv1; xv1 = xv2; xv2 = xv3;
            const float sq = wave_sum(qv * qv), sk = wave_sum(kv * kv);
            if (lane == 0) { red[(h * 2 + wv) * 2 + 0] = sq; red[(h * 2 + wv) * 2 + 1] = sk; }
            __syncthreads();
            const float ssq = red[(h * 2 + 0) * 2 + 0] + red[(h * 2 + 1) * 2 + 0], ssk = red[(h * 2 + 0) * 2 + 1] + red[(h * 2 + 1) * 2 + 1];
            const float nq = (1.0f / sqrtf(ssq + 1e-6f)) * 0.08838834764831845f, nk = 1.0f / sqrtf(ssk + 1e-6f);
            qs[h * 128 + c] = qv * nq; ks[h * 128 + c] = kv * nk;
            __syncthreads();
            const float xsp = ga + dtb; const float sp = xsp > 20.f ? xsp : log1pf(__expf(xsp));
            const float g = negA * sp, ea = __expf(g), beta = 1.f / (1.f + __expf(-gb));
            float kTS = 0.f;
#pragma unroll
            for (int k4 = 0; k4 < 32; ++k4) { const f32x4 kk = *(const LAS f32x4*)(ks + h * 128 + 4 * k4);
                kTS += kk.x * S[4 * k4] + kk.y * S[4 * k4 + 1] + kk.z * S[4 * k4 + 2] + kk.w * S[4 * k4 + 3];
                if ((k4 & 3) == 3) asm volatile("" ::: "memory"); }
            const float uu = beta * (vv - ea * kTS);
            float ov = 0.f;
#pragma unroll
            for (int k4 = 0; k4 < 32; ++k4) { const f32x4 kk = *(const LAS f32x4*)(ks + h * 128 + 4 * k4); const f32x4 qq = *(const LAS f32x4*)(qs + h * 128 + 4 * k4);
                S[4 * k4] = ea * S[4 * k4] + kk.x * uu; ov += qq.x * S[4 * k4];
                S[4 * k4 + 1] = ea * S[4 * k4 + 1] + kk.y * uu; ov += qq.y * S[4 * k4 + 1];
                S[4 * k4 + 2] = ea * S[4 * k4 + 2] + kk.z * uu; ov += qq.z * S[4 * k4 + 2];
                S[4 * k4 + 3] = ea * S[4 * k4 + 3] + kk.w * uu; ov += qq.w * S[4 * k4 + 3];
                if ((k4 & 3) == 3) asm volatile("" ::: "memory"); }
            const float so = wave_sum(ov * ov);
            if (lane == 0) red2[h * 2 + wv] = so;
            __syncthreads();
            const float rso = 1.0f / sqrtf((red2[h * 2] + red2[h * 2 + 1]) * (1.f / 128.f) + RMS_EPS);
            const float y = ov * rso * gnorm * siluf(gz);
            pr[PC_GZ + h * 128 + c] = (bf16)f2bf(y);
        }
        __syncthreads();
    }
}

__device__ __forceinline__ void p5_router(KArgs a, const Ctx& F) {
    LANE_TID;
    unsigned char* ws = a->ws;
    const float* x1 = a->out; bf16* hb = (bf16*)(ws + WS_HB);
    int* tok_e = (int*)(ws + WS_TOKE); float* tok_w = (float*)(ws + WS_TOKW); int* tok_r = (int*)(ws + WS_TOKR);
    unsigned* gcnt = (unsigned*)(ws + WS_CTL) + CW_CNT;
    LAS float* Wr = (LAS float*)(F.lds);
    LAS int* l_e = (LAS int*)(F.lds + 147456);
    LAS int* l_rank = l_e + 256;
    LAS float* l_w = (LAS float*)(l_rank + 256);
    LAS unsigned* lcnt = (LAS unsigned*)(l_w + 256);
    LAS unsigned* gbase = lcnt + 32;
    for (int idx = tid; idx < 4096; idx += NTHREADS) { const int k = idx >> 2, g = idx & 3; Wr[g * 1024 + k] = a->ffn_norm[k] * a->w_group[idx]; }
    for (int idx = tid; idx < 32768; idx += NTHREADS) { const int k = idx >> 5, e = idx & 31; Wr[(4 + e) * 1024 + k] = a->ffn_norm[k] * a->w_router[idx]; }
    f32x4 gn[4];
#pragma unroll
    for (int j = 0; j < 4; ++j) gn[j] = ((const f32x4*)a->ffn_norm)[64 * j + lane];
    for (int chunk = F.bid; chunk < T / 128; chunk += F.G) {
        if (tid < 32) lcnt[tid] = 0u;
        __syncthreads();
        for (int i = 0; i < 16; ++i) {
            const int lr = F.wave * 16 + i, m = chunk * 128 + lr;
            const f32x4* xr = (const f32x4*)(x1 + (size_t)m * D) + lane;
            f32x4 v[4]; float s = 0.f;
#pragma unroll
            for (int j = 0; j < 4; ++j) { v[j] = xr[64 * j]; s += (v[j].x * v[j].x + v[j].y * v[j].y) + (v[j].z * v[j].z + v[j].w * v[j].w); }
            const float rs = 1.0f / sqrtf(wave_sum(s) * (1.f / D) + RMS_EPS);
            uint2* o8 = (uint2*)(hb + (size_t)m * D) + lane;
#pragma unroll
            for (int j = 0; j < 4; ++j) { uint2 o; o.x = pk2(v[j].x * rs * gn[j].x, v[j].y * rs * gn[j].y); o.y = pk2(v[j].z * rs * gn[j].z, v[j].w * rs * gn[j].w); o8[64 * j] = o; }
            float lg[36];
#pragma unroll
            for (int o = 0; o < 36; ++o) { float acc = 0.f;
#pragma unroll
                for (int j = 0; j < 4; ++j) { const f32x4 w = *(const LAS f32x4*)(Wr + o * 1024 + 256 * j + 4 * lane); acc += (v[j].x * w.x + v[j].y * w.y) + (v[j].z * w.z + v[j].w * w.w); }
                lg[o] = wave_sum(acc) * rs; }
            int gs = 0; float gmax = lg[0];
#pragma unroll
            for (int g = 1; g < 4; ++g) if (lg[g] > gmax) { gmax = lg[g]; gs = g; }
            float gden = 0.f;
#pragma unroll
            for (int g = 0; g < 4; ++g) gden += __expf(lg[g] - gmax);
            const float pgrp = 1.f / gden;
            float il[8];
#pragma unroll
            for (int e = 0; e < 8; ++e) { float vsel = lg[4 + e];
#pragma unroll
                for (int g = 1; g < 4; ++g) vsel = (gs == g) ? lg[4 + 8 * g + e] : vsel;
                il[e] = vsel; }
            int i0 = 0; float m0 = il[0];
#pragma unroll
            for (int e = 1; e < 8; ++e) if (il[e] > m0) { m0 = il[e]; i0 = e; }
            int i1 = -1; float m1 = -INFINITY;
#pragma unroll
            for (int e = 0; e < 8; ++e) if (e != i0 && il[e] > m1) { m1 = il[e]; i1 = e; }
            const float e1 = __expf(m1 - m0), w0 = pgrp / (1.f + e1), w1 = pgrp * e1 / (1.f + e1);
            if (lane == 0) {
                const int ex0 = gs * 8 + i0, ex1 = gs * 8 + i1;
                l_e[lr * 2] = ex0; l_e[lr * 2 + 1] = ex1; l_w[lr * 2] = w0; l_w[lr * 2 + 1] = w1;
                l_rank[lr * 2] = (int)atomicAdd((unsigned*)&lcnt[ex0], 1u); l_rank[lr * 2 + 1] = (int)atomicAdd((unsigned*)&lcnt[ex1], 1u);
            }
        }
        __syncthreads();
        if (tid < 32) gbase[tid] = __hip_atomic_fetch_add(gcnt + tid, lcnt[tid], __ATOMIC_RELAXED, __HIP_MEMORY_SCOPE_AGENT);
        __syncthreads();
        if (tid < 256) { const int m2 = chunk * 256 + tid; const int e = l_e[tid];
            tok_e[m2] = e; tok_w[m2] = l_w[tid]; tok_r[m2] = (int)gbase[e] + l_rank[tid]; }
        __syncthreads();
    }
}

__device__ __forceinline__ void p6_gather(KArgs a, const Ctx& F) {
    LANE_TID;
    unsigned char* ws = a->ws;
    const bf16* hb = (const bf16*)(ws + WS_HB); bf16* xs = (bf16*)(ws + WS_XS);
    const int* tok_e = (const int*)(ws + WS_TOKE); const float* tok_w = (const float*)(ws + WS_TOKW); const int* tok_r = (const int*)(ws + WS_TOKR);
    int* rowmap = (int*)(ws + WS_ROWMAP); float* roww = (float*)(ws + WS_ROWW); int* tile_e = (int*)(ws + WS_TILEE);
    const unsigned* gcnt = (const unsigned*)(ws + WS_CTL) + CW_CNT; unsigned* ntw = (unsigned*)(ws + WS_CTL) + CW_NT;
    LAS int* off = (LAS int*)(F.lds);
    LAS int* cntl = off + 64;
    if (tid == 0) { int o = 0;
        for (int e = 0; e < NE; ++e) { const int c = (int)__hip_atomic_load(gcnt + e, __ATOMIC_RELAXED, __HIP_MEMORY_SCOPE_AGENT); off[e] = o; cntl[e] = c; o += ((c + 255) >> 8) << 8; }
        off[NE] = o; }
    __syncthreads();
    if (F.bid == 0) {
        const int nt = off[NE] >> 8;
        if (tid == 0) __hip_atomic_store(ntw, (unsigned)nt, __ATOMIC_RELAXED, __HIP_MEMORY_SCOPE_AGENT);
        for (int mt = tid; mt < nt; mt += NTHREADS) { int e = 0;
            for (int k = 1; k < NE; ++k) if (off[k] <= mt * 256) e = k;
            tile_e[mt] = e; }
        for (int e = 0; e < NE; ++e) for (int r = off[e] + cntl[e] + tid; r < off[e + 1]; r += NTHREADS) { rowmap[r] = 2 * T; roww[r] = 0.f; }
    }
    const int gw = F.bid * NWAVES + F.wave, NGW = F.G * NWAVES;
    for (int p = gw; p < 2 * T; p += NGW) {
        const int e = tok_e[p], r = off[e] + tok_r[p], t = p >> 1;
        const v4u* src = (const v4u*)(hb + (size_t)t * D); v4u* dst = (v4u*)(xs + (size_t)r * D);
        const v4u w0 = src[lane], w1 = src[64 + lane];
        dst[lane] = w0; dst[64 + lane] = w1;
        if (lane == 0) { rowmap[r] = p; roww[r] = tok_w[p]; }
    }
}

__device__ __forceinline__ void p9_final(KArgs a, const Ctx& F) {
    LANE_TID;
    const bf16* y2 = (const bf16*)(a->ws + WS_Y2);
    const int gw = F.bid * NWAVES + F.wave, NGW = F.G * NWAVES;
    f32x4 gn[4];
#pragma unroll
    for (int j = 0; j < 4; ++j) gn[j] = ((const f32x4*)a->final_norm)[64 * j + lane];
    for (int m = gw; m < T; m += NGW) {
        f32x4* xr = (f32x4*)(a->out + (size_t)m * D) + lane;
        const uint2* ya = (const uint2*)(y2 + (size_t)(2 * m) * D) + lane; const uint2* yb = (const uint2*)(y2 + (size_t)(2 * m + 1) * D) + lane;
        f32x4 v[4]; float s = 0.f;
#pragma unroll
        for (int j = 0; j < 4; ++j) { v[j] = xr[64 * j]; const uint2 p = ya[64 * j], q = yb[64 * j];
            v[j].x += bflo(p.x) + bflo(q.x); v[j].y += bfhi(p.x) + bfhi(q.x); v[j].z += bflo(p.y) + bflo(q.y); v[j].w += bfhi(p.y) + bfhi(q.y);
            s += (v[j].x * v[j].x + v[j].y * v[j].y) + (v[j].z * v[j].z + v[j].w * v[j].w); }
        const float rs = 1.0f / sqrtf(wave_sum(s) * (1.f / D) + RMS_EPS);
#pragma unroll
        for (int j = 0; j < 4; ++j) { f32x4 o; o.x = v[j].x * rs * gn[j].x; o.y = v[j].y * rs * gn[j].y; o.z = v[j].z * rs * gn[j].z; o.w = v[j].w * rs * gn[j].w; xr[64 * j] = o; }
    }
}

#ifndef MK_ONE_LAUNCH
#define MK_ONE_LAUNCH 1
#endif
constexpr int N_PHASES = 10;
__global__ void __launch_bounds__(NTHREADS, 2) mega_fwd(Args a_by_value) {
    const KArgs ka = (KArgs)__builtin_amdgcn_kernarg_segment_ptr();
#define KA() ({ KArgs q_ = ka; asm volatile("" : "+s"(q_)); q_; })
    extern __shared__ __attribute__((aligned(16))) unsigned char lds_raw[];
    Ctx F; F.lds = (LAS unsigned char*)lds_raw; F.wave = __builtin_amdgcn_readfirstlane((int)(threadIdx.x >> 6)); F.G = gridDim.x; F.bid = blockIdx.x;
#ifndef PH_MASK
#define PH_MASK 0x3ff
#endif
#define IN(k) (((PH_MASK >> (k)) & 1) && KA()->ph_lo <= (k) && (k) < KA()->ph_hi)
#define WSP() (KA()->ws)
#if MK_ONE_LAUNCH
#define MKBAR() XcdBarrier{(unsigned*)(WSP() + WS_CTL) + CW_BAR, xb_xcc_id(), (volatile LAS unsigned*)(F.lds + LDS_CTL_OFF)}
    {
        const int lane0 = lane_id(); const bool leader0 = (F.wave == 0 && lane0 == 0);
        if (F.wave == 0) ((LAS unsigned*)(F.lds + LDS_CTL_OFF))[lane0] = 0u;
        __syncthreads();
        (void)xcd_barrier_post((unsigned*)(WSP() + WS_CTL) + CW_BAR, (volatile LAS unsigned*)(F.lds + LDS_CTL_OFF), leader0);
        cg::this_grid().sync();
    }
#define SEAM(k) do { if (IN(k) && IN((k) + 1)) { const bool leader_ = (F.wave == 0 && lane_id() == 0); const XcdBarrier bar_ = MKBAR(); xcd_barrier(bar_, leader_, (unsigned)gridDim.x); } } while (0)
#else
#define SEAM(k) do { } while (0)
#endif
    if (IN(0)) p0_prologue(KA(), F);
    SEAM(0);
    if (IN(1)) {
        unsigned char* ws = WSP();
        pg8::Gemm g{(const pg8::bf16_t*)(ws + WS_HB), (const pg8::bf16_t*)(ws + WS_WIN), D, D};
        pg8::StaticOrder S; S.init(T, NP, F.G, F.bid);
        pg8::EpiStoreBf16 E{(pg8::bf16_t*)(ws + WS_P), NP, 512, attn_body::C2};
        pg8::gemm_phase<pg8::EpiStoreBf16, pg8::StaticOrder, true, true>(F.lds, g, S, E, F.wave);
    }
    SEAM(1);
    if (IN(2)) {
        p2_kmean(KA(), F);
        const KArgs q = KA(); unsigned char* ws = q->ws;
        gdn::prep_phase(F.lds, (const unsigned short*)(ws + WS_P), (const float*)(ws + WS_GAB), q->conv_w, q->A_log, q->dt_bias, ws + WS_GDN, (float*)(ws + WS_GLAST), F.wave, F.G, F.bid);
    }
    SEAM(2);
    if (IN(3)) {
        unsigned char* ws = WSP();
        gdn::scan_phase(F.lds, (unsigned short*)(ws + WS_P), ws + WS_GDN, (const float*)(ws + WS_GLAST), KA()->gdn_norm, F.wave, F.G, F.bid);
        const attn_body::bf16* Pb = (const attn_body::bf16*)(ws + WS_P);
        const attn_body::AttnTensors AT{Pb + PC_MQ, Pb + PC_MK, Pb + PC_MV, (attn_body::bf16*)(ws + WS_P) + PC_MQ, (const float*)(ws + WS_KMEAN)};
        const attn_body::StaticOrder S(F.G, F.bid);
        attn_body::attn_phase<attn_body::StaticOrder>((char*)lds_raw, AT, S, F.wave);
    }
    SEAM(3);
    if (IN(4)) {
        unsigned char* ws = WSP();
        pg8::Gemm g{(const pg8::bf16_t*)(ws + WS_P), (const pg8::bf16_t*)(ws + WS_WOUT), NP, D};
        pg8::StaticOrder S; S.init(T, D, F.G, F.bid);
        pg8::EpiResF32 E{KA()->x, KA()->out, D};
        pg8::gemm_phase<pg8::EpiResF32, pg8::StaticOrder, true, true>(F.lds, g, S, E, F.wave);
    }
    SEAM(4);
    if (IN(5)) p5_router(KA(), F);
    SEAM(5);
    if (IN(6)) p6_gather(KA(), F);
    SEAM(6);
    if (IN(7)) {
        unsigned char* ws = WSP();
        const int nt = (int)__hip_atomic_load((const unsigned*)(ws + WS_CTL) + CW_NT, __ATOMIC_RELAXED, __HIP_MEMORY_SCOPE_AGENT);
        pg8::Gemm g{(const pg8::bf16_t*)(ws + WS_XS), (const pg8::bf16_t*)(ws + WS_WGU), D, D};
        pg8::MoeOrder S{(const int*)(ws + WS_TILEE), nt, 2, F.G, F.bid};
        pg8::EpiGateUp E{(pg8::bf16_t*)(ws + WS_HID), (const float*)(ws + WS_ROWW)};
        pg8::gemm_phase<pg8::EpiGateUp, pg8::MoeOrder, true, true>(F.lds, g, S, E, F.wave);
    }
    SEAM(7);
    if (IN(8)) {
        unsigned char* ws = WSP();
        const int nt = (int)__hip_atomic_load((const unsigned*)(ws + WS_CTL) + CW_NT, __ATOMIC_RELAXED, __HIP_MEMORY_SCOPE_AGENT);
        pg8::Gemm g{(const pg8::bf16_t*)(ws + WS_HID), (const pg8::bf16_t*)(ws + WS_WD), FF, FF};
        pg8::MoeOrder S{(const int*)(ws + WS_TILEE), nt, 4, F.G, F.bid};
        pg8::EpiDown E{(pg8::bf16_t*)(ws + WS_Y2), (const int*)(ws + WS_ROWMAP)};
        pg8::gemm_phase<pg8::EpiDown, pg8::MoeOrder, true, true>(F.lds, g, S, E, F.wave);
    }
    SEAM(8);
    if (IN(9)) p9_final(KA(), F);
#undef IN
#undef SEAM
}

extern "C" void kernel_launch(void* const* d_in, const int* in_sizes, int n_in, void* d_out, int out_size, void* d_ws, size_t ws_size, hipStream_t stream) {
    static int grid = 0;
    if (grid == 0) {
        int dev = 0, cus = 0, per_cu = 0;
        hipGetDevice(&dev); hipDeviceGetAttribute(&cus, hipDeviceAttributeMultiprocessorCount, dev);
        hipFuncSetAttribute((const void*)mega_fwd, hipFuncAttributeMaxDynamicSharedMemorySize, LDS_BYTES);
        hipOccupancyMaxActiveBlocksPerMultiprocessor(&per_cu, (const void*)mega_fwd, NTHREADS, LDS_BYTES);
        if (per_cu < 1) { fprintf(stderr, "kernel_launch: occupancy query says %d blocks/CU\n", per_cu); per_cu = 1; }
        grid = cus * 1;
        if (ws_size < WS_END) { fprintf(stderr, "kernel_launch: workspace too small (%zu < %zu)\n", ws_size, (size_t)WS_END); grid = -1; }
    }
    if (grid < 0) return;
    hipMemsetAsync((char*)d_ws + WS_CTL, 0, CTL_ZERO_BYTES, stream);
    Args a{};
    a.x = (const float*)d_in[0]; a.attn_norm = (const float*)d_in[1]; a.w_in = (const float*)d_in[2]; a.conv_w = (const float*)d_in[3]; a.A_log = (const float*)d_in[4];
    a.dt_bias = (const float*)d_in[5]; a.gdn_norm = (const float*)d_in[6]; a.w_out = (const float*)d_in[7]; a.ffn_norm = (const float*)d_in[8]; a.w_group = (const float*)d_in[9];
    a.w_router = (const float*)d_in[10]; a.w_gate = (const float*)d_in[11]; a.w_up = (const float*)d_in[12]; a.w_down = (const float*)d_in[13]; a.final_norm = (const float*)d_in[14];
    a.out = (float*)d_out; a.ws = (unsigned char*)d_ws;
#if MK_ONE_LAUNCH
    a.ph_lo = 0; a.ph_hi = N_PHASES;
    void* args[] = {&a};
    hipError_t e = hipLaunchCooperativeKernel((const void*)mega_fwd, dim3(grid), dim3(NTHREADS), args, LDS_BYTES, stream);
    if (e != hipSuccess) fprintf(stderr, "cooperative launch failed: %s (grid %d)\n", hipGetErrorString(e), grid);
#else
    for (int p = 0; p < N_PHASES; ++p) { a.ph_lo = p; a.ph_hi = p + 1; hipLaunchKernelGGL(mega_fwd, dim3(grid), dim3(NTHREADS), LDS_BYTES, stream, a); }
#endif
}
```
